# Optimizing an MI355X kernel written in HIP

```python
import math
import jax, jax.numpy as jnp
from jax import lax
import numpy as np

D_MODEL = 1024
BATCH = 32
SEQ = 256
DEPTH = 4
DEC_BATCH = 8
DEC_SEQ = 2048
PAST_LEN = 512

GRID_W = 64
W_BR = D_MODEL
N_AB = (DEPTH + 1) // 2
N_CD = DEPTH // 2
H_A = 4
DK_A = W_BR // (2 * H_A)
DV_A = W_BR // H_A
GLA_RANK = 16
GLA_GATE_NORM = 16.0
H_B = 4
DK_B = W_BR // (2 * H_B)
DV_B = W_BR // H_B
RET_MIN_EXP = 5.0
RET_MAX_EXP = 12.0
CHUNK = 64
HY_EMB = 33
HY_HID = 64
HY_SHORT = 3
HY_N_FILT = 4
HY_FAST_DECAY = 0.3
HY_SLOW_DECAY = 1.5
HY_TARGET = 1e-2
LRU_CONV = 4
LRU_BLOCKS = 8
LRU_BS = W_BR // LRU_BLOCKS
LRU_C = 8.0
AB_IN = 2 * H_A * DK_A + W_BR + 2 * GLA_RANK + W_BR + 2 * H_B * DK_B + 2 * W_BR
CD_IN = 3 * W_BR + W_BR + W_BR + W_BR
EPS = 1e-6

kernel_name = 'hybrid_gla_retnet_hyena_rglru_diffusion_step'


def rms_norm(x, g):
    xf = x.astype(jnp.float32)
    y = xf * lax.rsqrt(jnp.mean(jnp.square(xf), axis=-1, keepdims=True) + EPS)
    return (y * g).astype(x.dtype)


def head_norm(o, g, center):
    if center:
        o = o - jnp.mean(o, axis=-1, keepdims=True)
    o = o * lax.rsqrt(jnp.mean(jnp.square(o), axis=-1, keepdims=True) + EPS)
    B, H, L, dv = o.shape
    return o.transpose(0, 2, 1, 3).reshape(B, L, H * dv) * g


def split_cols(t, sizes):
    return jnp.split(t, np.cumsum(sizes)[:-1].tolist(), axis=-1)


def depthwise_conv(x, w, b, pad_left):
    width = w.shape[0]
    L = x.shape[1]
    xp = jnp.pad(x, ((0, 0), (pad_left, width - 1 - pad_left), (0, 0)))
    return sum(xp[:, k:k + L] * w[k] for k in range(width)) + b


def chunked_gla(q, k, v, log_g, s0):
    B, H, L, dk = q.shape
    dv = v.shape[-1]
    n = L // CHUNK
    q = q.reshape(B, H, n, CHUNK, dk)
    k = k.reshape(B, H, n, CHUNK, dk)
    v = v.reshape(B, H, n, CHUNK, dv)
    b = jnp.cumsum(log_g.reshape(B, H, n, CHUNK, dk), axis=3)
    b_last = b[:, :, :, -1:, :]
    q_in = q * jnp.exp(b)
    k_in = k * jnp.exp(-b)
    k_st = k * jnp.exp(b_last - b)
    lower = jnp.tril(jnp.ones((CHUNK, CHUNK), dtype=bool))
    att = jnp.where(lower, jnp.einsum('bhnid,bhnjd->bhnij', q_in, k_in), 0.0)
    o_intra = jnp.einsum('bhnij,bhnjv->bhniv', att, v)
    kv = jnp.einsum('bhnjd,bhnjv->bhndv', k_st, v)
    decay = jnp.exp(b_last[:, :, :, 0, :])

    def step(s, xs):
        q_c, dec_c, kv_c = xs
        o_c = jnp.einsum('bhid,bhdv->bhiv', q_c, s)
        return dec_c[..., None] * s + kv_c, o_c

    s_final, o_inter = lax.scan(step, s0, (jnp.moveaxis(q_in, 2, 0), jnp.moveaxis(decay, 2, 0),
                                           jnp.moveaxis(kv, 2, 0)))
    o = o_intra + jnp.moveaxis(o_inter, 0, 2)
    return o.reshape(B, H, L, dv), s_final


def bidirectional_gla(q, k, v, lg_f, lg_b, s_f, s_b):
    o_f, last_f = chunked_gla(q, k, v, lg_f, s_f)
    fl = lambda t: jnp.flip(t, axis=2)
    o_b, last_b = chunked_gla(fl(q), fl(k), fl(v), fl(lg_b), s_b)
    return o_f + fl(o_b), jnp.stack([last_f, last_b], axis=1)


def retention_log_decay(direction):
    step = (RET_MAX_EXP - RET_MIN_EXP) / (H_B - 1)
    expo = RET_MIN_EXP + step * (jnp.arange(H_B, dtype=jnp.float32) + 0.5 * direction)
    return jnp.log1p(-jnp.exp2(-expo))


def hyena_filters(L, w1, b1, freq1, w2, b2, freq2, w3, b3):
    f32 = jnp.float32
    t = jnp.linspace(0.0, 1.0, L, dtype=f32)[:, None]
    bands = (HY_EMB - 1) // 2
    f = jnp.linspace(1e-4, bands - 1, bands, dtype=f32)[None, :]
    ang = (2.0 * math.pi / L) * jnp.arange(L, dtype=f32)[:, None] * f
    feats = jnp.concatenate([t, jnp.cos(ang), -jnp.sin(ang)], axis=-1)
    g = jnp.sin(freq1 * (feats @ w1 + b1))
    g = jnp.sin(freq2 * (g @ w2 + b2))
    filt = (g @ w3 + b3).reshape(L, HY_N_FILT, W_BR)
    deltas = jnp.abs(jnp.linspace(math.log(HY_TARGET) / HY_FAST_DECAY,
                                  math.log(HY_TARGET) / HY_SLOW_DECAY, W_BR, dtype=f32))
    window = jnp.exp(-t * deltas[None, :])
    return filt * window[:, None, :]


def long_conv(u, hf_fwd, hf_bwd, skip):
    L = u.shape[1]
    uf = jnp.fft.rfft(u, n=2 * L, axis=1)
    y = jnp.fft.irfft(uf * (hf_fwd + jnp.conj(hf_bwd))[None], n=2 * L, axis=1)[:, :L]
    return y + u * skip


def rg_lru(x, w_r, b_r, w_i, b_i, lam, h0):
    B, L, W = x.shape
    xb = x.reshape(B, L, LRU_BLOCKS, LRU_BS)
    r = jax.nn.sigmoid(jnp.einsum('blnc,ncd->blnd', xb, w_r).reshape(B, L, W) + b_r)
    i = jax.nn.sigmoid(jnp.einsum('blnc,ncd->blnd', xb, w_i).reshape(B, L, W) + b_i)
    log_a = -LRU_C * r * jax.nn.softplus(-lam)
    a = jnp.exp(log_a)
    b = jnp.sqrt(-jnp.expm1(2.0 * log_a)) * (i * x)
    b = b.at[:, 0].add(a[:, 0] * h0)
    _, h = lax.associative_scan(lambda l, rr: (l[0] * rr[0], rr[0] * l[1] + rr[1]), (a, b), axis=1)
    return h, h[:, -1]


def ab_mixer(h, lp, s_gla, s_ret):
    B, L, _ = h.shape
    f32 = jnp.float32
    proj = jnp.einsum('bld,de->ble', h, lp['ab_w_in']).astype(f32)
    qa, ka, va, ga, za, qb, kb, vb, zb = split_cols(
        proj, (H_A * DK_A, H_A * DK_A, W_BR, 2 * GLA_RANK, W_BR, H_B * DK_B, H_B * DK_B, W_BR, W_BR))

    def heads(t, n_heads):
        return t.reshape(B, L, n_heads, -1).transpose(0, 2, 1, 3)

    gate_logit = jnp.einsum('bldr,drk->bldk', ga.reshape(B, L, 2, GLA_RANK), lp['ab_gate_w2']) + lp['ab_gate_b']
    log_g = jax.nn.log_sigmoid(gate_logit) / GLA_GATE_NORM
    s_gla = s_gla.astype(f32)
    o_a, st_a = bidirectional_gla(heads(qa, H_A) * DK_A ** -0.5, heads(ka, H_A), heads(va, H_A),
                                  heads(log_g[:, :, 0], H_A), heads(log_g[:, :, 1], H_A),
                                  s_gla[:, 0], s_gla[:, 1])
    qb, kb, vb = heads(qb, H_B), heads(kb, H_B) * DK_B ** -0.5, heads(vb, H_B)
    dec_f = jnp.broadcast_to(retention_log_decay(0.0)[None, :, None, None], qb.shape)
    dec_b = jnp.broadcast_to(retention_log_decay(1.0)[None, :, None, None], qb.shape)
    s_ret = s_ret.astype(f32)
    o_b, st_b = bidirectional_gla(qb, kb, vb, dec_f, dec_b, s_ret[:, 0], s_ret[:, 1])
    y_a = head_norm(o_a, lp['ab_head_g'][:W_BR], False) * jax.nn.silu(za)
    y_b = head_norm(o_b, lp['ab_head_g'][W_BR:], True) * jax.nn.silu(zb)
    out = jnp.einsum('ble,ed->bld', jnp.concatenate([y_a, y_b], axis=-1).astype(h.dtype), lp['ab_w_out'])
    return out, st_a, st_b


def cd_mixer(h, lp, s_lru):
    B, L, _ = h.shape
    f32 = jnp.float32
    proj = jnp.einsum('bld,de->ble', h, lp['cd_w_in']).astype(f32)
    u, z_h, x_r, z_r = split_cols(proj, (3 * W_BR, W_BR, W_BR, W_BR))
    u = depthwise_conv(u, lp['hy_short_w'], lp['hy_short_b'], (HY_SHORT - 1) // 2)
    v, x1, x2 = jnp.split(u, 3, axis=-1)
    filt = hyena_filters(L, lp['hy_w1'], lp['hy_b1'], lp['hy_freq1'], lp['hy_w2'], lp['hy_b2'],
                         lp['hy_freq2'], lp['hy_w3'], lp['hy_b3'])
    filt_f = jnp.fft.rfft(filt, n=2 * L, axis=0)
    skip = lp['hy_skip']
    z = x1 * long_conv(v, filt_f[:, 0], filt_f[:, 1], skip[0])
    z = x2 * long_conv(z, filt_f[:, 2], filt_f[:, 3], skip[1])
    y_h = z * jax.nn.silu(z_h)
    xc = depthwise_conv(x_r, lp['lru_conv_w'], lp['lru_conv_b'], LRU_CONV // 2)
    s0 = s_lru.astype(f32)
    h_f, last_f = rg_lru(xc, lp['lru_w_r'][0], lp['lru_b_r'][0], lp['lru_w_i'][0], lp['lru_b_i'][0],
                         lp['lru_lambda'][0], s0[:, 0])
    h_b, last_b = rg_lru(jnp.flip(xc, axis=1), lp['lru_w_r'][1], lp['lru_b_r'][1], lp['lru_w_i'][1],
                         lp['lru_b_i'][1], lp['lru_lambda'][1], s0[:, 1])
    y_r = (h_f + jnp.flip(h_b, axis=1)) * jax.nn.silu(z_r)
    out = jnp.einsum('ble,ed->bld', jnp.concatenate([y_h, y_r], axis=-1).astype(h.dtype), lp['cd_w_out'])
    return out, jnp.stack([last_f, last_b], axis=1)


def run_trunk(x, cond, s_gla, s_ret, s_lru, p, collect):
    ab_keys = ('ab_w_in', 'ab_gate_w2', 'ab_gate_b', 'ab_head_g', 'ab_w_out')
    cd_keys = ('cd_w_in', 'hy_short_w', 'hy_short_b', 'hy_w1', 'hy_b1', 'hy_freq1', 'hy_w2', 'hy_b2',
               'hy_freq2', 'hy_w3', 'hy_b3', 'hy_skip', 'lru_conv_w', 'lru_conv_b', 'lru_w_r', 'lru_b_r',
               'lru_w_i', 'lru_b_i', 'lru_lambda', 'cd_w_out')
    new_gla, new_ret, new_lru = [], [], []
    for layer in range(DEPTH):
        i = layer // 2
        mod = jnp.einsum('bd,de->be', jax.nn.silu(cond), p['w_mod'][layer]) + p['b_mod'][layer]
        shift, scale, gate = jnp.split(mod[:, None, :], 3, axis=-1)
        h = rms_norm(x, p['norm_g'][layer]) * (1.0 + scale) + shift
        if layer % 2 == 0:
            lp = {name: p[name][i] for name in ab_keys}
            out, sg, sr = ab_mixer(h, lp, s_gla[:, i], s_ret[:, i])
            if collect:
                new_gla.append(sg)
                new_ret.append(sr)
        else:
            lp = {name: p[name][i] for name in cd_keys}
            out, sl = cd_mixer(h, lp, s_lru[:, i])
            if collect:
                new_lru.append(sl)
        x = x + (gate * out).astype(x.dtype)
    y = rms_norm(x, p['final_g'])
    return y, new_gla, new_ret, new_lru


def setup_inputs(seed: int = 0) -> dict:
    key = jax.random.key(seed)
    keys = iter(jax.random.split(key, 48))
    f32 = jnp.float32

    def nrm(shape, scale):
        return scale * jax.random.normal(next(keys), shape, f32)

    def gain(shape):
        return 1.0 + nrm(shape, 0.02)

    lam_u = jax.random.uniform(next(keys), (N_CD, 2, W_BR), f32, 0.9, 0.999)
    lam_a = lam_u ** (1.0 / LRU_C)
    lru_lambda = jnp.log(lam_a) - jnp.log1p(-lam_a)
    return {
        'x_prompt': nrm((BATCH, SEQ, D_MODEL), 1.0),
        'x_sample': nrm((DEC_BATCH, DEC_SEQ, D_MODEL), 1.0),
        'c': nrm((DEC_BATCH, D_MODEL), 1.0),
        'state_gla': nrm((DEC_BATCH, N_AB, 2, H_A, DK_A, DV_A), 0.1),
        'state_ret': nrm((DEC_BATCH, N_AB, 2, H_B, DK_B, DV_B), 0.1),
        'state_lru': nrm((DEC_BATCH, N_CD, 2, W_BR), 0.5),
        'c_ctx': nrm((D_MODEL,), 1.0),
        'norm_g': gain((DEPTH, D_MODEL)),
        'w_mod': nrm((DEPTH, D_MODEL, 3 * D_MODEL), 0.5 * D_MODEL ** -0.5),
        'b_mod': nrm((DEPTH, 3 * D_MODEL), 0.02),
        'ab_w_in': nrm((N_AB, D_MODEL, AB_IN), D_MODEL ** -0.5),
        'ab_gate_w2': nrm((N_AB, 2, GLA_RANK, H_A * DK_A), GLA_RANK ** -0.5),
        'ab_gate_b': nrm((N_AB, 2, H_A * DK_A), 0.1),
        'ab_head_g': gain((N_AB, 2 * W_BR)),
        'ab_w_out': nrm((N_AB, 2 * W_BR, D_MODEL), (2 * W_BR) ** -0.5),
        'cd_w_in': nrm((N_CD, D_MODEL, CD_IN), D_MODEL ** -0.5),
        'hy_short_w': nrm((N_CD, HY_SHORT, 3 * W_BR), HY_SHORT ** -0.5),
        'hy_short_b': nrm((N_CD, 3 * W_BR), 0.02),
        'hy_w1': nrm((N_CD, HY_EMB, HY_HID), HY_EMB ** -0.5),
        'hy_b1': nrm((N_CD, HY_HID), 0.1),
        'hy_freq1': gain((N_CD, HY_HID)),
        'hy_w2': nrm((N_CD, HY_HID, HY_HID), HY_HID ** -0.5),
        'hy_b2': nrm((N_CD, HY_HID), 0.1),
        'hy_freq2': gain((N_CD, HY_HID)),
        'hy_w3': nrm((N_CD, HY_HID, HY_N_FILT * W_BR), 0.05 * HY_HID ** -0.5),
        'hy_b3': nrm((N_CD, HY_N_FILT * W_BR), 0.01),
        'hy_skip': nrm((N_CD, 2, W_BR), 0.3),
        'lru_conv_w': nrm((N_CD, LRU_CONV, W_BR), LRU_CONV ** -0.5),
        'lru_conv_b': nrm((N_CD, W_BR), 0.02),
        'lru_w_r': nrm((N_CD, 2, LRU_BLOCKS, LRU_BS, LRU_BS), LRU_BS ** -0.5),
        'lru_b_r': nrm((N_CD, 2, W_BR), 0.1),
        'lru_w_i': nrm((N_CD, 2, LRU_BLOCKS, LRU_BS, LRU_BS), LRU_BS ** -0.5),
        'lru_b_i': nrm((N_CD, 2, W_BR), 0.1),
        'lru_lambda': lru_lambda,
        'cd_w_out': nrm((N_CD, 2 * W_BR, D_MODEL), (2 * W_BR) ** -0.5),
        'final_g': gain((D_MODEL,)),
    }


def reference(x_prompt, x_sample, c, state_gla, state_ret, state_lru, c_ctx, norm_g, w_mod, b_mod,
              ab_w_in, ab_gate_w2, ab_gate_b, ab_head_g, ab_w_out, cd_w_in, hy_short_w, hy_short_b,
              hy_w1, hy_b1, hy_freq1, hy_w2, hy_b2, hy_freq2, hy_w3, hy_b3, hy_skip, lru_conv_w,
              lru_conv_b, lru_w_r, lru_b_r, lru_w_i, lru_b_i, lru_lambda, cd_w_out, final_g):
    params = dict(norm_g=norm_g, w_mod=w_mod, b_mod=b_mod, ab_w_in=ab_w_in, ab_gate_w2=ab_gate_w2,
                  ab_gate_b=ab_gate_b, ab_head_g=ab_head_g, ab_w_out=ab_w_out, cd_w_in=cd_w_in,
                  hy_short_w=hy_short_w, hy_short_b=hy_short_b, hy_w1=hy_w1, hy_b1=hy_b1,
                  hy_freq1=hy_freq1, hy_w2=hy_w2, hy_b2=hy_b2, hy_freq2=hy_freq2, hy_w3=hy_w3,
                  hy_b3=hy_b3, hy_skip=hy_skip, lru_conv_w=lru_conv_w, lru_conv_b=lru_conv_b,
                  lru_w_r=lru_w_r, lru_b_r=lru_b_r, lru_w_i=lru_w_i, lru_b_i=lru_b_i,
                  lru_lambda=lru_lambda, cd_w_out=cd_w_out, final_g=final_g)
    B = x_prompt.shape[0]
    f32 = jnp.float32
    zero_gla = jnp.zeros((B, N_AB, 2, H_A, DK_A, DV_A), f32)
    zero_ret = jnp.zeros((B, N_AB, 2, H_B, DK_B, DV_B), f32)
    zero_lru = jnp.zeros((B, N_CD, 2, W_BR), f32)
    y_prompt, gla_list, ret_list, lru_list = run_trunk(x_prompt, c_ctx[None, :], zero_gla, zero_ret,
                                                       zero_lru, params, True)
    new_state_gla = jnp.stack(gla_list, axis=1).astype(x_prompt.dtype)
    new_state_ret = jnp.stack(ret_list, axis=1).astype(x_prompt.dtype)
    new_state_lru = jnp.stack(lru_list, axis=1).astype(x_prompt.dtype)
    y_sample = run_trunk(x_sample, c, state_gla, state_ret, state_lru, params, False)[0]
    return (y_prompt, y_sample, new_state_gla, new_state_ret, new_state_lru)
```

```cpp
#include <hip/hip_runtime.h>
#include <hip/hip_cooperative_groups.h>
#include <cstdio>
namespace cg = cooperative_groups;

typedef unsigned short u16;
using bf16x8 = __attribute__((ext_vector_type(8))) short;
using f32x4 = __attribute__((ext_vector_type(4))) float;
union V8 { bf16x8 v; uint4 u4; uint2 u2[2]; unsigned w[4]; u16 h[8]; };

#define TTOT 24576
#define TCTX 8192
#define NPAB 6272
#define OFF_GLA 25165824
#define OFF_RET 41943040
#define OFF_LRU 58720256
#define SMEM_BYTES 77824
#define NPHASE 22

struct Params {
  const float *x_prompt, *x_sample, *c, *state_gla, *state_ret, *state_lru, *c_ctx, *norm_g, *w_mod, *b_mod,
      *ab_w_in, *ab_gate_w2, *ab_gate_b, *ab_head_g, *ab_w_out, *cd_w_in, *hy_short_w, *hy_short_b,
      *hy_w1, *hy_b1, *hy_freq1, *hy_w2, *hy_b2, *hy_freq2, *hy_w3, *hy_b3, *hy_skip, *lru_conv_w,
      *lru_conv_b, *lru_w_r, *lru_b_r, *lru_w_i, *lru_b_i, *lru_lambda, *cd_w_out, *final_g;
  float* out;
  float* mod;
  float* ga32;
  u16 *wab_in, *wab_out, *wcd_in, *wcd_out, *wlru, *hrev, *H, *R1, *R2, *R3;
  unsigned* bar;
  float *pseg, *hseg;
};

typedef __bf16 bf2_t __attribute__((ext_vector_type(2)));
typedef float f2_t __attribute__((ext_vector_type(2)));
__device__ __forceinline__ unsigned pack2(float a, float b) {
  f2_t v = {a, b};
  return __builtin_bit_cast(unsigned, __builtin_convertvector(v, bf2_t));
}
__device__ __forceinline__ u16 f2bf(float f) { return (u16)(pack2(f, f) & 0xffffu); }
__device__ __forceinline__ float bf2f(u16 h) { return __uint_as_float(((unsigned)h) << 16); }
__device__ __forceinline__ float bflo(unsigned w) { return __uint_as_float(w << 16); }
__device__ __forceinline__ float bfhi(unsigned w) { return __uint_as_float(w & 0xffff0000u); }
__device__ __forceinline__ int cidx_of(int t) { return t < TCTX ? 0 : 1 + ((t - TCTX) >> 11); }
__device__ __forceinline__ float wave_sum(float v) {
#pragma unroll
  for (int off = 32; off > 0; off >>= 1) v += __shfl_xor(v, off);
  return v;
}
__device__ __forceinline__ float sigmoidf_(float x) { return __builtin_amdgcn_rcpf(1.f + __expf(-x)); }
__device__ __forceinline__ float siluf_(float x) { return x * __builtin_amdgcn_rcpf(1.f + __expf(-x)); }
__device__ __forceinline__ int tid_opaque() { int t = threadIdx.x; asm volatile("" : "+v"(t)); return t; }
typedef __attribute__((address_space(3))) void* lds_ptr_t;
typedef const __attribute__((address_space(1))) void* gbl_ptr_t;
#define MFMA(a, b, c) __builtin_amdgcn_mfma_f32_16x16x32_bf16((a), (b), (c), 0, 0, 0)

__device__ __forceinline__ size_t hrev_off(int li, int grp, int o, int c) {
  size_t base = (size_t)li * 9437184u;
  if (grp == 0) return base + (size_t)(o * 1024 + c) * 512;
  return base + 1048576u + (size_t)(o * 1024 + c) * 4096;
}


#define XB_TMO      128
#define XB_XCNT(j)  (256  + 64 * (j))
#define XB_XSUB(j)  (1280 + 64 * (j))
#define XB_XGEN(j)  (2304 + 64 * (j))
#define XB_TOP      3328
#define XB_TOPGEN   3392
#define XCD_BAR_WORDS 3456
#define XB_SPIN_CAP (1u << 20)
#define LAS __attribute__((address_space(3)))
__device__ __forceinline__ unsigned xb_ld(unsigned* p) { return __hip_atomic_load(p, __ATOMIC_RELAXED, __HIP_MEMORY_SCOPE_AGENT); }
__device__ __forceinline__ unsigned xb_add(unsigned* p, unsigned v) { return __hip_atomic_fetch_add(p, v, __ATOMIC_RELAXED, __HIP_MEMORY_SCOPE_AGENT); }
__device__ __forceinline__ unsigned xb_xcc_id() { return (unsigned)__builtin_amdgcn_s_getreg((3 << 11) | 20) & 0xFu; }
#define XB_SPIN(cond, bar) do { unsigned _sp = 0; while (cond) { __builtin_amdgcn_s_sleep(1); \
    if ((++_sp & 255u) == 0u) { if (xb_ld(&(bar)[XB_TMO])) break; if (_sp > XB_SPIN_CAP) { atomicAdd(&(bar)[XB_TMO], 1u); break; } } } } while (0)
struct XcdBarrier { unsigned* bar; unsigned x; volatile LAS unsigned* st; };
__device__ __forceinline__ XcdBarrier xcd_barrier_post(unsigned* bar, volatile LAS unsigned* st) {
  XcdBarrier b; b.bar = bar; b.x = xb_xcc_id(); b.st = st;
  if (threadIdx.x == 0) (void)xb_add(&bar[XB_XCNT(b.x)], 1u);
  return b;
}
__device__ __forceinline__ void xcd_barrier_complete(unsigned* bar, unsigned x, unsigned& nloc, unsigned& nx) {
  const unsigned G = gridDim.x * gridDim.y * gridDim.z;
  unsigned sum, cnt, mine, sp = 0u;
  for (;;) {
    sum = 0u; cnt = 0u; mine = 0u;
#pragma unroll
    for (unsigned j = 0; j < 16; ++j) { const unsigned c = xb_ld(&bar[XB_XCNT(j)]); sum += c; cnt += (c > 0u) ? 1u : 0u; mine = (j == x) ? c : mine; }
    if (sum == G) break;
    __builtin_amdgcn_s_sleep(1);
    if ((++sp & 255u) == 0u) { if (xb_ld(&bar[XB_TMO])) break; if (sp > XB_SPIN_CAP) { atomicAdd(&bar[XB_TMO], 1u); break; } }
  }
  nloc = mine > 0u ? mine : 1u; nx = cnt > 0u ? cnt : 1u;
}
__device__ __forceinline__ void xcd_barrier(const XcdBarrier& b) {
  asm volatile("s_waitcnt vmcnt(0)" ::: "memory");
  __syncthreads();
  if (threadIdx.x == 0) {
    unsigned* bar = b.bar;
    __builtin_amdgcn_s_waitcnt(0);
    unsigned nloc = b.st[0], nx = b.st[1];
    if (nloc == 0u) { xcd_barrier_complete(bar, b.x, nloc, nx); b.st[0] = nloc; b.st[1] = nx; }
    const unsigned old = xb_add(&bar[XB_XSUB(b.x)], 1u);
    const unsigned gen = old / nloc;
    if (old + 1u == (gen + 1u) * nloc) {
      __builtin_amdgcn_fence(__ATOMIC_RELEASE, "agent");
      asm volatile("s_waitcnt vmcnt(0)" ::: "memory");
      const unsigned og = xb_add(&bar[XB_TOP], 1u);
      const unsigned tg = og / nx;
      if (og + 1u == (tg + 1u) * nx) xb_add(&bar[XB_TOPGEN], 1u);
      else XB_SPIN(xb_ld(&bar[XB_TOPGEN]) == tg, bar);
      __builtin_amdgcn_fence(__ATOMIC_ACQUIRE, "agent");
      xb_add(&bar[XB_XGEN(b.x)], 1u);
      asm volatile("s_waitcnt vmcnt(0)" ::: "memory");
    } else {
      XB_SPIN(xb_ld(&bar[XB_XGEN(b.x)]) == gen, bar);
      __builtin_amdgcn_fence(__ATOMIC_ACQUIRE, "agent");
      asm volatile("s_waitcnt vmcnt(0)" ::: "memory");
    }
  }
  __syncthreads();
}

__device__ void p0_mod(const Params& p, int u, char* smem) {
  float* sc = (float*)smem;
  float* red = sc + 9 * 1024;
  const int tid = tid_opaque();
  const int layer = u / 96, col0 = (u % 96) * 32;
  __syncthreads();
#pragma unroll 1
  for (int i0 = 0; i0 < 36; i0 += 9) {
    float v[9];
#pragma unroll
    for (int i = 0; i < 9; ++i) {
      const int idx = tid + 256 * (i0 + i), ci = idx >> 10, k = idx & 1023;
      v[i] = ci == 0 ? p.c_ctx[k] : p.c[(ci - 1) * 1024 + k];
    }
#pragma unroll
    for (int i = 0; i < 9; ++i) sc[tid + 256 * (i0 + i)] = v[i] * __builtin_amdgcn_rcpf(1.f + __expf(-v[i]));
  }
  __syncthreads();
  const int col = tid & 31, kg = tid >> 5;
  float acc[9];
#pragma unroll
  for (int ci = 0; ci < 9; ++ci) acc[ci] = 0.f;
  const float* wp = p.w_mod + (size_t)layer * 1024 * 3072 + col0 + col;
#pragma unroll 1
  for (int k0 = kg * 128; k0 < kg * 128 + 128; k0 += 16) {
    float wv[16];
#pragma unroll
    for (int i = 0; i < 16; ++i) wv[i] = wp[(size_t)(k0 + i) * 3072];
#pragma unroll
    for (int i = 0; i < 16; ++i)
#pragma unroll
      for (int ci = 0; ci < 9; ++ci) acc[ci] += sc[ci * 1024 + k0 + i] * wv[i];
  }
#pragma unroll
  for (int ci = 0; ci < 9; ++ci) red[(kg * 9 + ci) * 32 + col] = acc[ci];
  __syncthreads();
  for (int idx = tid; idx < 288; idx += 256) {
    int ci = idx >> 5, cc = idx & 31;
    float v = p.b_mod[layer * 3072 + col0 + cc];
#pragma unroll
    for (int g = 0; g < 8; ++g) v += red[(g * 9 + ci) * 32 + cc];
    p.mod[(layer * 9 + ci) * 3072 + col0 + cc] = v;
  }
}

__device__ void p0_trans_tile(const float* __restrict__ src, int N, u16* __restrict__ dst, int K, int k0, int n0,
                              char* smem) {
  float* tile = (float*)smem;
  const int tid = tid_opaque();
  __syncthreads();
  {
    float4 v[4];
#pragma unroll
    for (int i = 0; i < 4; ++i) {
      const int id = tid + 256 * i, kk = id >> 4, c4 = id & 15;
      const int n = n0 + c4 * 4;
      v[i] = n < N ? *(const float4*)(src + (size_t)(k0 + kk) * N + n) : make_float4(0.f, 0.f, 0.f, 0.f);
    }
#pragma unroll
    for (int i = 0; i < 4; ++i) {
      const int id = tid + 256 * i, kk = id >> 4, c4 = id & 15;
      float* t = tile + kk * 65 + c4 * 4;
      t[0] = v[i].x; t[1] = v[i].y; t[2] = v[i].z; t[3] = v[i].w;
    }
  }
  __syncthreads();
#pragma unroll
  for (int i = 0; i < 2; ++i) {
    const int id = tid + 256 * i, nn = id >> 3, kc = id & 7;
    const float* t = tile + (kc * 8) * 65 + nn;
    uint4 o;
    o.x = pack2(t[0], t[65]); o.y = pack2(t[130], t[195]); o.z = pack2(t[260], t[325]); o.w = pack2(t[390], t[455]);
    *(uint4*)(dst + (size_t)(n0 + nn) * K + k0 + kc * 8) = o;
  }
}

__device__ void p0_trans(const Params& p, int u, char* smem) {
  if (u < 3136) {
    int lay = u / 1568, r = u % 1568, kt = r / 98, nt = r % 98;
    p0_trans_tile(p.ab_w_in + (size_t)lay * 1024 * 6176, 6176, p.wab_in + (size_t)lay * NPAB * 1024, 1024, kt * 64,
                  nt * 64, smem);
  } else if (u < 4160) {
    int v = u - 3136, lay = v / 512, r = v % 512, kt = r / 16, nt = r % 16;
    p0_trans_tile(p.ab_w_out + (size_t)lay * 2048 * 1024, 1024, p.wab_out + (size_t)lay * 1024 * 2048, 2048, kt * 64,
                  nt * 64, smem);
  } else if (u < 7232) {
    int v = u - 4160, lay = v / 1536, r = v % 1536, kt = r / 96, nt = r % 96;
    p0_trans_tile(p.cd_w_in + (size_t)lay * 1024 * 6144, 6144, p.wcd_in + (size_t)lay * 6144 * 1024, 1024, kt * 64,
                  nt * 64, smem);
  } else if (u < 8256) {
    int v = u - 7232, lay = v / 512, r = v % 512, kt = r / 16, nt = r % 16;
    p0_trans_tile(p.cd_w_out + (size_t)lay * 2048 * 1024, 1024, p.wcd_out + (size_t)lay * 1024 * 2048, 2048, kt * 64,
                  nt * 64, smem);
  } else {
    int v = u - 8256, ri = v / 128, r = v % 128, mat = r / 4, t4 = r % 4, kt = t4 / 2, nt = t4 % 2;
    p0_trans_tile((ri ? p.lru_w_i : p.lru_w_r) + (size_t)mat * 16384, 128, p.wlru + (size_t)(mat * 2 + ri) * 16384,
                  128, kt * 64, nt * 64, smem);
  }
}

__device__ void p0_hyf(const Params& p, int u, char* smem) {
  float* g1s = (float*)smem;
  float* g2s = g1s + 4096;
  float* fts = g2s + 4096;
  const int tid = tid_opaque();
  const int li = u / 576;
  int r = u % 576, grp, ptile, ctile;
  if (r < 64) { grp = 0; ptile = r / 16; ctile = r % 16; }
  else { grp = 1; r -= 64; ptile = r / 16; ctile = r % 16; }
  const int L = grp ? 2048 : 256;
  const int pl = tid & 63;
  const int hg = __builtin_amdgcn_readfirstlane(tid >> 6);
  const int pg = ptile * 64 + pl;
  const float tpos = (float)pg / (float)(L - 1);
  __syncthreads();
  for (int f = hg; f < 33; f += 4) {
    float v;
    if (f == 0) v = tpos;
    else {
      const int bi = (f - 1) & 15;
      const float fb = 1e-4f + (float)bi * ((15.f - 1e-4f) / 15.f);
      float turns = (float)pg * fb * (1.f / (float)L);
      turns -= floorf(turns);
      const float ang = 6.283185307179586f * turns;
      v = f <= 16 ? __cosf(ang) : -__sinf(ang);
    }
    fts[f * 64 + pl] = v;
  }
  __syncthreads();
#pragma unroll 1
  for (int hh = 0; hh < 16; ++hh) {
    const int h = hg * 16 + hh;
    float s = p.hy_b1[li * 64 + h];
#pragma unroll 11
    for (int f = 0; f < 33; ++f) s += fts[f * 64 + pl] * p.hy_w1[(li * 33 + f) * 64 + h];
    g1s[h * 64 + pl] = __sinf(p.hy_freq1[li * 64 + h] * s);
  }
  __syncthreads();
#pragma unroll 1
  for (int hh = 0; hh < 16; ++hh) {
    const int h2 = hg * 16 + hh;
    float s = p.hy_b2[li * 64 + h2];
#pragma unroll 16
    for (int h = 0; h < 64; ++h) s += g1s[h * 64 + pl] * p.hy_w2[(li * 64 + h) * 64 + h2];
    g2s[h2 * 64 + pl] = __sinf(p.hy_freq2[li * 64 + h2] * s);
  }
  __syncthreads();
  float center[16];
#pragma unroll
  for (int cc = 0; cc < 16; ++cc) center[cc] = 0.f;
  const float A0 = -15.350567286626973f, A1 = -3.0701134573253945f;
#pragma unroll 1
  for (int f = 0; f < 4; ++f) {
    const int cb = f * 1024 + ctile * 64 + hg * 16;
    float a16[16];
#pragma unroll
    for (int cc = 0; cc < 16; ++cc) a16[cc] = p.hy_b3[li * 4096 + cb + cc];
    const float* w3 = p.hy_w3 + (size_t)li * 64 * 4096 + cb;
#pragma unroll 4
    for (int j = 0; j < 64; ++j) {
      const float g = g2s[j * 64 + pl];
#pragma unroll
      for (int cc = 0; cc < 16; ++cc) a16[cc] += g * w3[(size_t)j * 4096 + cc];
    }
    const int o = f >> 1;
#pragma unroll
    for (int cc = 0; cc < 16; ++cc) {
      const int c = ctile * 64 + hg * 16 + cc;
      const float delta = fabsf(A0 + (float)c * ((A1 - A0) / 1023.f));
      const float val = a16[cc] * __expf(-tpos * delta);
      u16* hr = p.hrev + hrev_off(li, grp, o, c);
      if (!(f & 1)) {
        if (pg == 0) { center[cc] = val; hr[0] = 0; }
        else hr[L - pg] = f2bf(val);
      } else {
        if (pg == 0) hr[L] = f2bf(center[cc] + val + p.hy_skip[(li * 2 + o) * 1024 + c]);
        else hr[L + pg] = f2bf(val);
      }
    }
  }
}

__device__ void norm_rows(const Params& p, int layer, const float* xp, const float* xs, int vb, int G) {
  const int tid_ = tid_opaque(); const int wave = tid_ >> 6, lane = tid_ & 63;
  for (int row = vb * 4 + wave; row < TTOT; row += G * 4) {
    const float* xr = row < TCTX ? xp + (size_t)row * 1024 : xs + (size_t)(row - TCTX) * 1024;
    float4 v[4];
    float ss = 0.f;
#pragma unroll
    for (int j = 0; j < 4; ++j) {
      v[j] = *(const float4*)(xr + j * 256 + lane * 4);
      ss += v[j].x * v[j].x + v[j].y * v[j].y + v[j].z * v[j].z + v[j].w * v[j].w;
    }
    ss = wave_sum(ss);
    const float rstd = rsqrtf(ss * (1.f / 1024.f) + 1e-6f);
    const float* md = p.mod + (size_t)(layer * 9 + cidx_of(row)) * 3072;
    const float* g = p.norm_g + layer * 1024;
#pragma unroll
    for (int j = 0; j < 4; ++j) {
      int col = j * 256 + lane * 4;
      float4 gg = *(const float4*)(g + col), sh = *(const float4*)(md + col), sl = *(const float4*)(md + 1024 + col);
      float h0 = v[j].x * rstd * gg.x * (1.f + sl.x) + sh.x;
      float h1 = v[j].y * rstd * gg.y * (1.f + sl.y) + sh.y;
      float h2 = v[j].z * rstd * gg.z * (1.f + sl.z) + sh.z;
      float h3 = v[j].w * rstd * gg.w * (1.f + sl.w) + sh.w;
      uint2 o; o.x = pack2(h0, h1); o.y = pack2(h2, h3);
      *(uint2*)(p.H + (size_t)row * 1024 + col) = o;
    }
  }
}

__device__ void final_norm(const Params& p, int vb, int G) {
  const int tid_ = tid_opaque(); const int wave = tid_ >> 6, lane = tid_ & 63;
  for (int row = vb * 4 + wave; row < TTOT; row += G * 4) {
    float* xr = p.out + (size_t)row * 1024;
    float4 v[4];
    float ss = 0.f;
#pragma unroll
    for (int j = 0; j < 4; ++j) {
      v[j] = *(const float4*)(xr + j * 256 + lane * 4);
      ss += v[j].x * v[j].x + v[j].y * v[j].y + v[j].z * v[j].z + v[j].w * v[j].w;
    }
    ss = wave_sum(ss);
    const float rstd = rsqrtf(ss * (1.f / 1024.f) + 1e-6f);
#pragma unroll
    for (int j = 0; j < 4; ++j) {
      int col = j * 256 + lane * 4;
      float4 gg = *(const float4*)(p.final_g + col);
      float4 o;
      o.x = v[j].x * rstd * gg.x; o.y = v[j].y * rstd * gg.y; o.z = v[j].z * rstd * gg.z; o.w = v[j].w * rstd * gg.w;
      *(float4*)(xr + col) = o;
    }
  }
}

__device__ void headnorm_rows(const Params& p, int li, int vb, int G) {
  const int tid_ = tid_opaque(); const int wave = tid_ >> 6, lane = tid_ & 63;
  u16* OF = p.R2; const u16* OB = p.R3; const u16* PROJ = p.R1;
  const int stride = G * 4;
  for (int item0 = vb * 4 + wave; item0 < TTOT * 8; item0 += 4 * stride) {
    uint2 a[4], b[4], z[4];
#pragma unroll
    for (int k = 0; k < 4; ++k) {
      const int item = item0 + k * stride;
      if (item < TTOT * 8) {
        const int t = item >> 3, hh = item & 7;
        const int col0 = hh * 256 + lane * 4;
        const int zc = (hh < 4 ? 2080 + hh * 256 : 5152 + (hh - 4) * 256) + lane * 4;
        a[k] = *(const uint2*)(OF + (size_t)t * 2048 + col0);
        b[k] = *(const uint2*)(OB + (size_t)t * 2048 + col0);
        z[k] = *(const uint2*)(PROJ + (size_t)t * NPAB + zc);
      } else { a[k] = make_uint2(0, 0); b[k] = a[k]; z[k] = a[k]; }
    }
#pragma unroll
    for (int k = 0; k < 4; ++k) {
      const int item = item0 + k * stride;
      if (item >= TTOT * 8) break;
      const int t = item >> 3, hh = item & 7;
      const int col0 = hh * 256 + lane * 4;
      float o0 = bflo(a[k].x) + bflo(b[k].x), o1 = bfhi(a[k].x) + bfhi(b[k].x);
      float o2 = bflo(a[k].y) + bflo(b[k].y), o3 = bfhi(a[k].y) + bfhi(b[k].y);
      if (hh >= 4) {
        float m = wave_sum(o0 + o1 + o2 + o3) * (1.f / 256.f);
        o0 -= m; o1 -= m; o2 -= m; o3 -= m;
      }
      float ss = wave_sum(o0 * o0 + o1 * o1 + o2 * o2 + o3 * o3) * (1.f / 256.f);
      const float rstd = rsqrtf(ss + 1e-6f);
      float4 g = *(const float4*)(p.ab_head_g + li * 2048 + col0);
      float y0 = o0 * rstd * g.x * siluf_(bflo(z[k].x));
      float y1 = o1 * rstd * g.y * siluf_(bfhi(z[k].x));
      float y2 = o2 * rstd * g.z * siluf_(bflo(z[k].y));
      float y3 = o3 * rstd * g.w * siluf_(bfhi(z[k].y));
      uint2 y; y.x = pack2(y0, y1); y.y = pack2(y2, y3);
      *(uint2*)(OF + (size_t)t * 2048 + col0) = y;
    }
  }
}

template <int MODE>
__device__ __forceinline__ void gemm_tile(const Params& p, const u16* __restrict__ A, int lda,
                                          const u16* __restrict__ Bt, int K, int m0, int n0, int layer,
                                          const float* xp, const float* xs, char* smem, float* xdst = nullptr) {
  const int tid = tid_opaque(), lane = tid & 63, w = tid >> 6, l = lane & 15, q = lane >> 4;
  const int wm = w >> 1, wn = w & 1;
  f32x4 acc[4][4];
#pragma unroll
  for (int mi = 0; mi < 4; ++mi)
#pragma unroll
    for (int ni = 0; ni < 4; ++ni) acc[mi][ni] = (f32x4){0.f, 0.f, 0.f, 0.f};
  const int nk = K >> 5;
  const int r0 = tid >> 2, c0 = (tid & 3) ^ ((-(r0 >> 2)) & 3);
  const int r1 = 64 + r0;
  const u16* ga0 = A + (size_t)(m0 + r0) * lda + c0 * 8;
  const u16* ga1 = A + (size_t)(m0 + r1) * lda + c0 * 8;
  const u16* gb0 = Bt + (size_t)(n0 + r0) * K + c0 * 8;
  const u16* gb1 = Bt + (size_t)(n0 + r1) * K + c0 * 8;
  char* ldst = smem + tid * 16;
#define GISSUE(KT)                                                                                         \
  {                                                                                                        \
    char* st_ = ldst + ((KT) & 3) * 16384;                                                                 \
    const int ko_ = (KT) * 32;                                                                             \
    __builtin_amdgcn_global_load_lds((gbl_ptr_t)(ga0 + ko_), (lds_ptr_t)(st_), 16, 0, 0);                  \
    __builtin_amdgcn_global_load_lds((gbl_ptr_t)(ga1 + ko_), (lds_ptr_t)(st_ + 4096), 16, 0, 0);           \
    __builtin_amdgcn_global_load_lds((gbl_ptr_t)(gb0 + ko_), (lds_ptr_t)(st_ + 8192), 16, 0, 0);           \
    __builtin_amdgcn_global_load_lds((gbl_ptr_t)(gb1 + ko_), (lds_ptr_t)(st_ + 12288), 16, 0, 0);          \
  }
  GISSUE(0)
  GISSUE(1)
  GISSUE(2)
  const int aoff = (wm * 64 + l) * 64 + ((q ^ ((-(l >> 2)) & 3)) * 16);
  const int boff = 8192 + (wn * 64 + l) * 64 + ((q ^ ((-(l >> 2)) & 3)) * 16);
  bf16x8 a0[4], b0[4], a1[4], b1[4];
#define GWAIT(KT)                                                            \
  if ((KT) + 2 < nk) asm volatile("s_waitcnt vmcnt(8)" ::: "memory");        \
  else if ((KT) + 1 < nk) asm volatile("s_waitcnt vmcnt(4)" ::: "memory");   \
  else asm volatile("s_waitcnt vmcnt(0)" ::: "memory");                      \
  __builtin_amdgcn_s_barrier();
#define GREAD(KT, AF, BF)                                                    \
  {                                                                          \
    const char* st_ = smem + ((KT) & 3) * 16384;                             \
    _Pragma("unroll") for (int mi = 0; mi < 4; ++mi) AF[mi] = *(const bf16x8*)(st_ + aoff + mi * 1024); \
    _Pragma("unroll") for (int ni = 0; ni < 4; ++ni) BF[ni] = *(const bf16x8*)(st_ + boff + ni * 1024); \
  }
#define GMMA(AF, BF)                                                         \
  _Pragma("unroll") for (int mi = 0; mi < 4; ++mi)                           \
  _Pragma("unroll") for (int ni = 0; ni < 4; ++ni) acc[mi][ni] = MFMA(AF[mi], BF[ni], acc[mi][ni]);
  GWAIT(0)
  GREAD(0, a0, b0)
#pragma unroll 1
  for (int kt = 0; kt < nk; kt += 2) {
    if (kt + 3 < nk) GISSUE(kt + 3)
    GWAIT(kt + 1)
    GREAD(kt + 1, a1, b1)
    GMMA(a0, b0)
    if (kt + 2 < nk) {
      if (kt + 4 < nk) GISSUE(kt + 4)
      GWAIT(kt + 2)
      GREAD(kt + 2, a0, b0)
    }
    GMMA(a1, b1)
  }
  __syncthreads();
  if (MODE == 2) {
    float* tile = (float*)smem;
#pragma unroll
    for (int mi = 0; mi < 4; ++mi)
#pragma unroll
      for (int ni = 0; ni < 4; ++ni)
#pragma unroll
        for (int r = 0; r < 4; ++r)
          tile[(wm * 64 + mi * 16 + q * 4 + r) * 132 + wn * 64 + ni * 16 + l] = acc[mi][ni][r];
    __syncthreads();
#pragma unroll 4
    for (int i = 0; i < 16; ++i) {
      const int id = tid + 256 * i, row = id >> 5, cc = id & 31;
      const int grow = m0 + row, gcol = n0 + cc * 4;
      const float4 v = *(const float4*)(tile + row * 132 + cc * 4);
      const float4 g = *(const float4*)(p.mod + (size_t)(layer * 9 + cidx_of(grow)) * 3072 + 2048 + gcol);
      const float* xr = grow < TCTX ? xp + (size_t)grow * 1024 + gcol : xs + (size_t)(grow - TCTX) * 1024 + gcol;
      const float4 xi = *(const float4*)xr;
      float4 o;
      o.x = xi.x + g.x * v.x; o.y = xi.y + g.y * v.y; o.z = xi.z + g.z * v.z; o.w = xi.w + g.w * v.w;
      *(float4*)(xdst + (size_t)grow * 1024 + gcol) = o;
    }
  } else if (MODE == 1 && n0 < 3072) {
    u16* tile = (u16*)smem;
#pragma unroll
    for (int mi = 0; mi < 4; ++mi)
#pragma unroll
      for (int ni = 0; ni < 4; ++ni) {
        uint2 o; o.x = pack2(acc[mi][ni][0], acc[mi][ni][1]); o.y = pack2(acc[mi][ni][2], acc[mi][ni][3]);
        *(uint2*)(tile + (wn * 64 + ni * 16 + l) * 136 + wm * 64 + mi * 16 + q * 4) = o;
      }
    __syncthreads();
#pragma unroll
    for (int i = 0; i < 8; ++i) {
      const int id = tid + 256 * i, col = id >> 4, cc = id & 15;
      *(uint4*)(p.R1 + (size_t)(n0 + col) * TTOT + m0 + cc * 8) = *(const uint4*)(tile + col * 136 + cc * 8);
    }
  } else {
    u16* tile = (u16*)smem;
#pragma unroll
    for (int mi = 0; mi < 4; ++mi)
#pragma unroll
      for (int ni = 0; ni < 4; ++ni)
#pragma unroll
        for (int r = 0; r < 4; ++r)
          tile[(wm * 64 + mi * 16 + q * 4 + r) * 136 + wn * 64 + ni * 16 + l] = f2bf(acc[mi][ni][r]);
    if (MODE == 0 && n0 == 2048 && wn == 0) {
#pragma unroll
      for (int mi = 0; mi < 4; ++mi)
#pragma unroll
        for (int ni = 0; ni < 2; ++ni)
#pragma unroll
          for (int r = 0; r < 4; ++r)
            p.ga32[(size_t)(m0 + wm * 64 + mi * 16 + q * 4 + r) * 32 + ni * 16 + l] = acc[mi][ni][r];
    }
    __syncthreads();
    u16* dst = MODE == 0 ? p.R1 + (size_t)m0 * NPAB + n0 : p.R1 + (size_t)3072 * TTOT + (size_t)m0 * 3072 + (n0 - 3072);
    const int ldd = MODE == 0 ? NPAB : 3072;
#pragma unroll
    for (int i = 0; i < 8; ++i) {
      const int id = tid + 256 * i, row = id >> 4, cc = id & 15;
      *(uint4*)(dst + (size_t)row * ldd + cc * 8) = *(const uint4*)(tile + row * 136 + cc * 8);
    }
  }
  __syncthreads();
}

template <int MODE>
__device__ __forceinline__ void gemm_big(const Params& p, const u16* __restrict__ A, const u16* __restrict__ Bt,
                                         int m0, int n0, char* smem, const int K = 1024, int layer = 0,
                                         const float* xp = nullptr, const float* xs = nullptr) {
  const int nk = K >> 5;
  const int tid = tid_opaque(), lane = tid & 63, w = tid >> 6, l = lane & 15, q = lane >> 4;
  const int wm = w >> 1, wn = w & 1;
  f32x4 acc[8][4];
#pragma unroll
  for (int mi = 0; mi < 8; ++mi)
#pragma unroll
    for (int ni = 0; ni < 4; ++ni) acc[mi][ni] = (f32x4){0.f, 0.f, 0.f, 0.f};
  const int r0 = tid >> 2, c0 = (tid & 3) ^ ((-(r0 >> 2)) & 3);
  const u16* ga = A + (size_t)(m0 + r0) * K + c0 * 8;
  const u16* gb = Bt + (size_t)(n0 + r0) * K + c0 * 8;
  const size_t r64 = (size_t)64 * K;
  char* ldst = smem + tid * 16;
#define BISSUE(KT, BUF)                                                                                      \
  {                                                                                                          \
    char* st_ = ldst + (BUF) * 24576;                                                                        \
    const int ko_ = (KT) * 32;                                                                               \
    __builtin_amdgcn_global_load_lds((gbl_ptr_t)(ga + ko_), (lds_ptr_t)(st_), 16, 0, 0);                     \
    __builtin_amdgcn_global_load_lds((gbl_ptr_t)(ga + r64 + ko_), (lds_ptr_t)(st_ + 4096), 16, 0, 0);      \
    __builtin_amdgcn_global_load_lds((gbl_ptr_t)(ga + 2 * r64 + ko_), (lds_ptr_t)(st_ + 8192), 16, 0, 0);     \
    __builtin_amdgcn_global_load_lds((gbl_ptr_t)(ga + 3 * r64 + ko_), (lds_ptr_t)(st_ + 12288), 16, 0, 0);    \
    __builtin_amdgcn_global_load_lds((gbl_ptr_t)(gb + ko_), (lds_ptr_t)(st_ + 16384), 16, 0, 0);             \
    __builtin_amdgcn_global_load_lds((gbl_ptr_t)(gb + r64 + ko_), (lds_ptr_t)(st_ + 20480), 16, 0, 0);     \
  }
  BISSUE(0, 0)
  BISSUE(1, 1)
  const int swz = (q ^ ((-(l >> 2)) & 3)) * 16;
  const int aoff = (wm * 128 + l) * 64 + swz;
  const int boff = 16384 + (wn * 64 + l) * 64 + swz;
  int buf = 0;
#pragma unroll 1
  for (int kt = 0; kt < nk; ++kt) {
    if (kt + 1 < nk) asm volatile("s_waitcnt vmcnt(6)" ::: "memory");
    else asm volatile("s_waitcnt vmcnt(0)" ::: "memory");
    __builtin_amdgcn_s_barrier();
    if (kt + 2 < nk) {
      const int nb = buf == 0 ? 2 : buf - 1;
      BISSUE(kt + 2, nb)
    }
    const char* st = smem + buf * 24576;
    bf16x8 b[4];
#pragma unroll
    for (int ni = 0; ni < 4; ++ni) b[ni] = *(const bf16x8*)(st + boff + ni * 1024);
#pragma unroll
    for (int mi = 0; mi < 8; ++mi) {
      const bf16x8 a = *(const bf16x8*)(st + aoff + mi * 1024);
#pragma unroll
      for (int ni = 0; ni < 4; ++ni) acc[mi][ni] = MFMA(a, b[ni], acc[mi][ni]);
    }
    buf = buf == 2 ? 0 : buf + 1;
  }
  __syncthreads();
  if (MODE == 2) {
    float* tile = (float*)smem;
#pragma unroll 1
    for (int h = 0; h < 2; ++h) {
      if (wm == h) {
#pragma unroll
        for (int mi = 0; mi < 8; ++mi)
#pragma unroll
          for (int ni = 0; ni < 4; ++ni)
#pragma unroll
            for (int r = 0; r < 4; ++r) tile[(mi * 16 + q * 4 + r) * 132 + wn * 64 + ni * 16 + l] = acc[mi][ni][r];
      }
      __syncthreads();
#pragma unroll 4
      for (int i = 0; i < 16; ++i) {
        const int id = tid + 256 * i, row = id >> 5, cc = id & 31;
        const int grow = m0 + h * 128 + row, gcol = n0 + cc * 4;
        const float4 v = *(const float4*)(tile + row * 132 + cc * 4);
        const float4 gg = *(const float4*)(p.mod + (size_t)(layer * 9 + cidx_of(grow)) * 3072 + 2048 + gcol);
        const float* xr = grow < TCTX ? xp + (size_t)grow * 1024 + gcol : xs + (size_t)(grow - TCTX) * 1024 + gcol;
        const float4 xi = *(const float4*)xr;
        float4 o;
        o.x = xi.x + gg.x * v.x; o.y = xi.y + gg.y * v.y; o.z = xi.z + gg.z * v.z; o.w = xi.w + gg.w * v.w;
        *(float4*)(p.out + (size_t)grow * 1024 + gcol) = o;
      }
      __syncthreads();
    }
    return;
  }
  if (MODE == 1 && n0 < 3072) {
    u16* tile = (u16*)smem;
#pragma unroll
    for (int mi = 0; mi < 8; ++mi)
#pragma unroll
      for (int ni = 0; ni < 4; ++ni) {
        uint2 o; o.x = pack2(acc[mi][ni][0], acc[mi][ni][1]); o.y = pack2(acc[mi][ni][2], acc[mi][ni][3]);
        *(uint2*)(tile + (wn * 64 + ni * 16 + l) * 264 + wm * 128 + mi * 16 + q * 4) = o;
      }
    __syncthreads();
#pragma unroll 4
    for (int i = 0; i < 16; ++i) {
      const int id = tid + 256 * i, col = id >> 5, cc = id & 31;
      *(uint4*)(p.R1 + (size_t)(n0 + col) * TTOT + m0 + cc * 8) = *(const uint4*)(tile + col * 264 + cc * 8);
    }
  } else {
    u16* tile = (u16*)smem;
#pragma unroll
    for (int mi = 0; mi < 8; ++mi)
#pragma unroll
      for (int ni = 0; ni < 4; ++ni)
#pragma unroll
        for (int r = 0; r < 4; ++r)
          tile[(wm * 128 + mi * 16 + q * 4 + r) * 136 + wn * 64 + ni * 16 + l] = f2bf(acc[mi][ni][r]);
    if (MODE == 0 && n0 == 2048 && wn == 0) {
#pragma unroll
      for (int mi = 0; mi < 8; ++mi)
#pragma unroll
        for (int ni = 0; ni < 2; ++ni)
#pragma unroll
          for (int r = 0; r < 4; ++r)
            p.ga32[(size_t)(m0 + wm * 128 + mi * 16 + q * 4 + r) * 32 + ni * 16 + l] = acc[mi][ni][r];
    }
    __syncthreads();
    u16* dst = MODE == 0 ? p.R1 + (size_t)m0 * NPAB + n0 : p.R1 + (size_t)3072 * TTOT + (size_t)m0 * 3072 + (n0 - 3072);
    const int ldd = MODE == 0 ? NPAB : 3072;
#pragma unroll 4
    for (int i = 0; i < 16; ++i) {
      const int id = tid + 256 * i, row = id >> 4, cc = id & 15;
      *(uint4*)(dst + (size_t)row * ldd + cc * 8) = *(const uint4*)(tile + row * 136 + cc * 8);
    }
  }
  __syncthreads();
}

__device__ __forceinline__ void gemm_thin(const Params& p, const u16* __restrict__ A, const u16* __restrict__ Bt,
                                          int m0, char* smem) {
  const int n0 = 6144;
  const int tid = tid_opaque(), lane = tid & 63, w = tid >> 6, l = lane & 15, q = lane >> 4;
  f32x4 acc[4][2];
#pragma unroll
  for (int mi = 0; mi < 4; ++mi)
#pragma unroll
    for (int ni = 0; ni < 2; ++ni) acc[mi][ni] = (f32x4){0.f, 0.f, 0.f, 0.f};
  const int r0 = tid >> 2, c0 = (tid & 3) ^ ((-(r0 >> 2)) & 3);
  const u16* ga = A + (size_t)(m0 + r0) * 1024 + c0 * 8;
  const u16* gb = Bt + (size_t)(n0 + (r0 & 31)) * 1024 + c0 * 8;
  char* ldst = smem + tid * 16;
  const bool bl = w < 2;
#define TISSUE(KT, BUF)                                                                                      \
  {                                                                                                          \
    char* st_ = ldst + (BUF) * 24576;                                                                        \
    const int ko_ = (KT) * 32;                                                                               \
    __builtin_amdgcn_global_load_lds((gbl_ptr_t)(ga + ko_), (lds_ptr_t)(st_), 16, 0, 0);                     \
    __builtin_amdgcn_global_load_lds((gbl_ptr_t)(ga + 65536 + ko_), (lds_ptr_t)(st_ + 4096), 16, 0, 0);      \
    __builtin_amdgcn_global_load_lds((gbl_ptr_t)(ga + 131072 + ko_), (lds_ptr_t)(st_ + 8192), 16, 0, 0);     \
    __builtin_amdgcn_global_load_lds((gbl_ptr_t)(ga + 196608 + ko_), (lds_ptr_t)(st_ + 12288), 16, 0, 0);    \
    if (bl) __builtin_amdgcn_global_load_lds((gbl_ptr_t)(gb + ko_), (lds_ptr_t)(st_ + 16384), 16, 0, 0);     \
  }
  TISSUE(0, 0)
  TISSUE(1, 1)
  const int swz = (q ^ ((-(l >> 2)) & 3)) * 16;
  const int aoff = (w * 64 + l) * 64 + swz;
  const int boff = 16384 + l * 64 + swz;
  int buf = 0;
#pragma unroll 1
  for (int kt = 0; kt < 32; ++kt) {
    if (kt + 1 < 32) {
      if (bl) asm volatile("s_waitcnt vmcnt(5)" ::: "memory");
      else asm volatile("s_waitcnt vmcnt(4)" ::: "memory");
    } else asm volatile("s_waitcnt vmcnt(0)" ::: "memory");
    __builtin_amdgcn_s_barrier();
    if (kt + 2 < 32) {
      const int nb = buf == 0 ? 2 : buf - 1;
      TISSUE(kt + 2, nb)
    }
    const char* st = smem + buf * 24576;
    bf16x8 b[2];
#pragma unroll
    for (int ni = 0; ni < 2; ++ni) b[ni] = *(const bf16x8*)(st + boff + ni * 1024);
#pragma unroll
    for (int mi = 0; mi < 4; ++mi) {
      const bf16x8 a = *(const bf16x8*)(st + aoff + mi * 1024);
#pragma unroll
      for (int ni = 0; ni < 2; ++ni) acc[mi][ni] = MFMA(a, b[ni], acc[mi][ni]);
    }
    buf = buf == 2 ? 0 : buf + 1;
  }
  __syncthreads();
  u16* tile = (u16*)smem;
#pragma unroll
  for (int mi = 0; mi < 4; ++mi)
#pragma unroll
    for (int ni = 0; ni < 2; ++ni)
#pragma unroll
      for (int r = 0; r < 4; ++r) tile[(w * 64 + mi * 16 + q * 4 + r) * 40 + ni * 16 + l] = f2bf(acc[mi][ni][r]);
  __syncthreads();
#pragma unroll
  for (int i = 0; i < 4; ++i) {
    const int id = tid + 256 * i, row = id >> 2, cc = id & 3;
    *(uint4*)(p.R1 + (size_t)(m0 + row) * NPAB + n0 + cc * 8) = *(const uint4*)(tile + row * 40 + cc * 8);
  }
  __syncthreads();
}

__device__ __forceinline__ void gla_step23(f32x4 (&S)[8], const int vrow0, const u16* VT, const u16* ATT, const u16* Qs,
                                           const u16* KT, const float* DEC, u16* O, const int w, const int l,
                                           const int q, const int tokbase, const int dir, const int cpos,
                                           const int ocol) {
    {
      f32x4 oacc[4];
#pragma unroll
      for (int ni = 0; ni < 4; ++ni) oacc[ni] = (f32x4){0.f, 0.f, 0.f, 0.f};
      bf16x8 vfr[2];
#pragma unroll
      for (int ks = 0; ks < 2; ++ks) {
        vfr[ks] = *(const bf16x8*)(VT + (vrow0 + l) * 72 + ((32 * ks + 8 * q) ^ (8 * (((vrow0 + l) >> 3) & 7))));
#pragma unroll
        for (int ni = 0; ni < 4; ++ni) {
          bf16x8 bfr = *(const bf16x8*)(ATT + (16 * ni + l) * 72 + 32 * ks + 8 * q);
          oacc[ni] = MFMA(vfr[ks], bfr, oacc[ni]);
        }
      }
      __builtin_amdgcn_sched_barrier(0);
#pragma unroll
      for (int pp = 0; pp < 4; ++pp) {
        V8 sa;
        sa.w[0] = pack2(S[2 * pp][0], S[2 * pp][1]);
        sa.w[1] = pack2(S[2 * pp][2], S[2 * pp][3]);
        sa.w[2] = pack2(S[2 * pp + 1][0], S[2 * pp + 1][1]);
        sa.w[3] = pack2(S[2 * pp + 1][2], S[2 * pp + 1][3]);
#pragma unroll
        for (int ni = 0; ni < 4; ++ni) {
          V8 bq;
          bq.u2[0] = *(const uint2*)(Qs + (16 * ni + l) * 136 + 32 * pp + 4 * q);
          bq.u2[1] = *(const uint2*)(Qs + (16 * ni + l) * 136 + 32 * pp + 16 + 4 * q);
          oacc[ni] = MFMA(sa.v, bq.v, oacc[ni]);
        }
      }
      __builtin_amdgcn_sched_barrier(0);
#pragma unroll
      for (int ni = 0; ni < 4; ++ni) {
        const int i = 16 * ni + l;
        const int tok = tokbase + (dir ? cpos + 63 - i : cpos + i);
        uint2 o; o.x = pack2(oacc[ni][0], oacc[ni][1]); o.y = pack2(oacc[ni][2], oacc[ni][3]);
        *(uint2*)(O + (size_t)tok * 2048 + ocol + vrow0 + 4 * q) = o;
      }
      __builtin_amdgcn_sched_barrier(0);
#pragma unroll
      for (int mi = 0; mi < 8; ++mi) {
        if ((mi & 1) == 0) __builtin_amdgcn_sched_barrier(0);
#pragma unroll
        for (int ks = 0; ks < 2; ++ks) {
          bf16x8 a = *(const bf16x8*)(KT + (16 * mi + l) * 72 + 32 * ks + 8 * q);
          S[mi] = MFMA(a, vfr[ks], S[mi]);
        }
        const float4 dc = *(const float4*)(DEC + 16 * mi + 4 * q);
        S[mi][0] *= dc.x; S[mi][1] *= dc.y; S[mi][2] *= dc.z; S[mi][3] *= dc.w;
      }
    }
}

__device__ void gla_unit(const Params& p, int li, int unit, char* smem) {
  u16* Qs = (u16*)smem;
  u16* Ks = Qs + 64 * 136;
  u16* KT = Ks + 64 * 136;
  u16* VT = KT + 128 * 72;
  u16* GAh = VT + 64 * 72;
  float* DEC = (float*)(GAh + 64 * 40);
  u16* ATT = (u16*)(DEC + 128);
  const int tid = tid_opaque(), lane = tid & 63, w = tid >> 6, l = lane & 15, q = lane >> 4;
  int b, tokbase, nch, u = unit;
  bool latent;
  if (unit < 512) { latent = true; b = u >> 6; tokbase = TCTX + b * 2048; nch = 32; }
  else { latent = false; u = unit - 512; b = u >> 6; tokbase = b * 256; nch = 4; }
  const int sl = u & 3, dir = (u >> 2) & 1, hd = (u >> 3) & 3, ty = (u >> 5) & 1;
  const int qcol = ty == 0 ? hd * 128 : 3104 + hd * 128;
  const int kcol = ty == 0 ? 512 + hd * 128 : 3616 + hd * 128;
  const int vcol = (ty == 0 ? 1024 : 4128) + hd * 256 + sl * 64;
  const int ocol = ty * 1024 + hd * 256 + sl * 64;
  const u16* PROJ = p.R1;
  u16* O = dir ? p.R3 : p.R2;
  V8 w2h[2];
  float gb[2] = {0.f, 0.f};
  float ldec = 0.f;
#pragma unroll
  for (int ni = 0; ni < 2; ++ni) w2h[ni].u4 = make_uint4(0, 0, 0, 0);
  if (ty == 0) {
#pragma unroll
    for (int ni = 0; ni < 2; ++ni) {
      const int d = 32 * w + 16 * ni + l;
      const float* wp = p.ab_gate_w2 + (size_t)((li * 2 + dir) * 16 + 8 * (q & 1)) * 512 + hd * 128 + d;
      float hv[8];
#pragma unroll
      for (int e = 0; e < 8; ++e) hv[e] = wp[e * 512];
#pragma unroll
      for (int e = 0; e < 4; ++e) w2h[ni].w[e] = pack2(hv[2 * e], hv[2 * e + 1]);
      gb[ni] = p.ab_gate_b[(li * 2 + dir) * 512 + hd * 128 + d];
    }
  } else {
    float expo = 5.f + (7.f / 3.f) * ((float)hd + 0.5f * (float)dir);
    ldec = log1pf(-exp2f(-expo));
  }
  const float qs = ty == 0 ? 0.08838834764831845f : 1.f;
  const float ksc = ty == 0 ? 1.f : 0.08838834764831845f;
  f32x4 S0[8];
  const size_t sbase = ((((size_t)b * 2 + li) * 2 + dir) * 4 + hd) * 128 * 256;
  const int svcol = sl * 64 + 16 * w + l;
  if (latent) {
    const float* sin_ = ty == 0 ? p.state_gla : p.state_ret;
#pragma unroll
    for (int mi = 0; mi < 8; ++mi)
#pragma unroll
      for (int r = 0; r < 4; ++r) S0[mi][r] = sin_[sbase + (size_t)(16 * mi + 4 * q + r) * 256 + svcol];
  } else {
#pragma unroll
    for (int mi = 0; mi < 8; ++mi) S0[mi] = (f32x4){0.f, 0.f, 0.f, 0.f};
  }
  uint4 rq0, rq1, rq2, rq3, rk0, rk1, rk2, rk3, rv0, rv1;
  float4 rga;
  const int qrow = tid >> 4, qcc = tid & 15;
  const int vrow = tid >> 3, vcc = tid & 7;
  const int grow = tid >> 2, gcc = tid & 3;
#define GLA_TOK(CP, ROW) (tokbase + (dir ? (CP) + 63 - (ROW) : (CP) + (ROW)))
#define GLA_PREFETCH(CP)                                                                              \
  {                                                                                                   \
    const u16* b0_ = PROJ + (size_t)GLA_TOK(CP, qrow) * NPAB + qcc * 8;                               \
    const u16* b1_ = PROJ + (size_t)GLA_TOK(CP, qrow + 16) * NPAB + qcc * 8;                          \
    const u16* b2_ = PROJ + (size_t)GLA_TOK(CP, qrow + 32) * NPAB + qcc * 8;                          \
    const u16* b3_ = PROJ + (size_t)GLA_TOK(CP, qrow + 48) * NPAB + qcc * 8;                          \
    rq0 = *(const uint4*)(b0_ + qcol); rk0 = *(const uint4*)(b0_ + kcol);                             \
    rq1 = *(const uint4*)(b1_ + qcol); rk1 = *(const uint4*)(b1_ + kcol);                             \
    rq2 = *(const uint4*)(b2_ + qcol); rk2 = *(const uint4*)(b2_ + kcol);                             \
    rq3 = *(const uint4*)(b3_ + qcol); rk3 = *(const uint4*)(b3_ + kcol);                             \
  }
#define GLA_PREFETCH_V(CP)                                                                            \
  {                                                                                                   \
    rv0 = *(const uint4*)(PROJ + (size_t)GLA_TOK(CP, vrow) * NPAB + vcc * 8 + vcol);                  \
    rv1 = *(const uint4*)(PROJ + (size_t)GLA_TOK(CP, vrow + 32) * NPAB + vcc * 8 + vcol);             \
    rga = *(const float4*)(p.ga32 + (size_t)GLA_TOK(CP, grow) * 32 + dir * 16 + gcc * 4);             \
  }
  {
    const int cpos0 = 64 * (dir ? nch - 1 : 0);
    GLA_PREFETCH(cpos0)
    GLA_PREFETCH_V(cpos0)
  }
#pragma unroll 1
  for (int n = 0; n < nch; ++n) {
    const int cpos = 64 * (dir ? nch - 1 - n : n);
    __syncthreads();
    {
      u16* dq = Qs + qrow * 136 + qcc * 8;
      u16* dk = Ks + qrow * 136 + qcc * 8;
      *(uint4*)(dq) = rq0; *(uint4*)(dq + 16 * 136) = rq1; *(uint4*)(dq + 32 * 136) = rq2; *(uint4*)(dq + 48 * 136) = rq3;
      *(uint4*)(dk) = rk0; *(uint4*)(dk + 16 * 136) = rk1; *(uint4*)(dk + 32 * 136) = rk2; *(uint4*)(dk + 48 * 136) = rk3;
      V8 t0, t1; t0.u4 = rv0; t1.u4 = rv1;
#pragma unroll
      for (int e = 0; e < 8; ++e) {
        u16* vp = VT + (vcc * 8 + e) * 72;
        vp[vrow ^ (8 * vcc)] = t0.h[e]; vp[(vrow + 32) ^ (8 * vcc)] = t1.h[e];
      }
      if (ty == 0) {
        const float h0 = bf2f(f2bf(rga.x)), h1 = bf2f(f2bf(rga.y)), h2 = bf2f(f2bf(rga.z)), h3 = bf2f(f2bf(rga.w));
        uint2 hi, lo;
        hi.x = pack2(h0, h1); hi.y = pack2(h2, h3);
        lo.x = pack2(rga.x - h0, rga.y - h1); lo.y = pack2(rga.z - h2, rga.w - h3);
        *(uint2*)(GAh + grow * 40 + gcc * 4) = hi;
        *(uint2*)(GAh + grow * 40 + 16 + gcc * 4) = lo;
      }
    }
    __syncthreads();
    if (n + 1 < nch) {
      const int cpos2 = 64 * (dir ? nch - 2 - n : n + 1);
      GLA_PREFETCH(cpos2)
    }
    {
      float carry[2] = {0.f, 0.f};
#pragma unroll
      for (int mi = 0; mi < 4; ++mi) {
        bf16x8 a;
        float eqs[4] = {0.f, 0.f, 0.f, 0.f}, eks[4] = {0.f, 0.f, 0.f, 0.f};
        if (ty == 0) a = *(const bf16x8*)(GAh + (16 * mi + l) * 40 + 8 * q);
#pragma unroll
        for (int ni = 0; ni < 2; ++ni) {
          float c[4];
          if (ty == 0) {
            f32x4 lg = (f32x4){0.f, 0.f, 0.f, 0.f};
            lg = MFMA(a, w2h[ni].v, lg);
            float run = 0.f;
#pragma unroll
            for (int r = 0; r < 4; ++r) {
              const float s = lg[r] + gb[ni];
              run += (fminf(s, 0.f) - __logf(1.f + __expf(-fabsf(s)))) * (1.f / 16.f);
              c[r] = run;
            }
            const float T = run;
            const float u1 = __shfl_up(T, 16);
            const float T1 = q >= 1 ? T + u1 : T;
            const float u2 = __shfl_up(T1, 32);
            const float T2 = q >= 2 ? T1 + u2 : T1;
            const float tot = __shfl(T2, 48 + l);
            const float base = carry[ni] + (T2 - T);
#pragma unroll
            for (int r = 0; r < 4; ++r) c[r] += base;
            carry[ni] += tot;
          } else {
#pragma unroll
            for (int r = 0; r < 4; ++r) c[r] = (float)(16 * mi + 4 * q + r + 1) * ldec;
          }
          const int j0 = 16 * mi + 4 * q, d = 32 * w + 16 * ni + l;
          float ks4[4];
          float eq[4], ek[4];
          if (ty == 0 || ni == 0) {
#pragma unroll
            for (int r = 0; r < 4; ++r) { eq[r] = qs * __expf(c[r]); ek[r] = ksc * __expf(-c[r]); }
          }
          if (ty != 0 && ni == 0) {
#pragma unroll
            for (int r = 0; r < 4; ++r) { eqs[r] = eq[r]; eks[r] = ek[r]; }
          }
          if (ty != 0 && ni != 0) {
#pragma unroll
            for (int r = 0; r < 4; ++r) { eq[r] = eqs[r]; ek[r] = eks[r]; }
          }
#pragma unroll
          for (int r = 0; r < 4; ++r) {
            u16* qp = Qs + (j0 + r) * 136 + d;
            u16* kp = Ks + (j0 + r) * 136 + d;
            const float qv = bf2f(*qp), kv = bf2f(*kp);
            *qp = f2bf(qv * eq[r]);
            ks4[r] = kv * ek[r];
            *kp = f2bf(ks4[r]);
          }
          uint2 o; o.x = pack2(ks4[0], ks4[1]); o.y = pack2(ks4[2], ks4[3]);
          *(uint2*)(KT + d * 72 + j0) = o;
        }
      }
      if (q == 0) {
        DEC[32 * w + l] = __expf(ty == 0 ? carry[0] : 64.f * ldec);
        DEC[32 * w + 16 + l] = __expf(ty == 0 ? carry[1] : 64.f * ldec);
      }
    }
    __syncthreads();
    __builtin_amdgcn_sched_barrier(0);
    f32x4 at[4];
#pragma unroll
    for (int ni = 0; ni < 4; ++ni) at[ni] = (f32x4){0.f, 0.f, 0.f, 0.f};
#pragma unroll
    for (int ks = 0; ks < 4; ++ks) {
      bf16x8 a = *(const bf16x8*)(Qs + (16 * w + l) * 136 + 32 * ks + 8 * q);
#pragma unroll
      for (int ni = 0; ni < 4; ++ni) {
        bf16x8 bfr = *(const bf16x8*)(Ks + (16 * ni + l) * 136 + 32 * ks + 8 * q);
        at[ni] = MFMA(a, bfr, at[ni]);
      }
    }
#pragma unroll
    for (int ni = 0; ni < 4; ++ni)
#pragma unroll
      for (int r = 0; r < 4; ++r) {
        const int i = 16 * w + 4 * q + r, j = 16 * ni + l;
        ATT[i * 72 + j] = f2bf(j <= i ? at[ni][r] : 0.f);
      }
    __syncthreads();
    __builtin_amdgcn_sched_barrier(0);
    gla_step23(S0, 16 * w, VT, ATT, Qs, KT, DEC, O, w, l, q, tokbase, dir, cpos, ocol);
    __builtin_amdgcn_sched_barrier(0);
    if (n + 1 < nch) {
      const int cpos3 = 64 * (dir ? nch - 2 - n : n + 1);
      GLA_PREFETCH_V(cpos3)
    }
  }
  if (!latent) {
    float* so = p.out + (ty == 0 ? OFF_GLA : OFF_RET);
#pragma unroll
    for (int mi = 0; mi < 8; ++mi)
#pragma unroll
      for (int r = 0; r < 4; ++r) so[sbase + (size_t)(16 * mi + 4 * q + r) * 256 + svcol] = S0[mi][r];
  }
}

template <int GRP>
__device__ void conv_unit(const Params& p, int li, int c, char* smem) {
  constexpr int L = GRP ? 2048 : 256;
  constexpr int NB = GRP ? 8 : 32;
  constexpr int NI = GRP ? 4 : 2;
  constexpr int NIB = L / 64;
  constexpr int TOK0 = GRP ? TCTX : 0;
  constexpr int HCS = 2 * L + 8;
  constexpr int UBS = L + 8;
  constexpr int CPT = NB * L / 8 / 256;
  u16* HC = (u16*)smem;
  u16* UB = HC + 4 * HCS;
  u16* XR = GRP ? HC : UB + NB * UBS;
  const int tid = tid_opaque(), lane = tid & 63, w = tid >> 6, l = lane & 15, q = lane >> 4;
  const u16* UT = p.R1;
  u16* Z2T = p.H;
  const float* sw = p.hy_short_w + li * 3 * 3072;
  const float* sb = p.hy_short_b + li * 3072;
  __syncthreads();
  {
    const u16* src = UT + (size_t)c * TTOT + TOK0;
    uint4 raw[CPT];
#pragma unroll
    for (int k = 0; k < CPT; ++k) raw[k] = *(const uint4*)(src + (size_t)(tid + 256 * k) * 8);
#pragma unroll
    for (int k = 0; k < CPT; ++k) {
      const int ch = tid + 256 * k, bq = ch / (L / 8), p0 = (ch % (L / 8)) * 8;
      *(uint4*)(UB + bq * UBS + p0) = raw[k];
    }
    __syncthreads();
    const float w0 = sw[c], w1 = sw[3072 + c], w2 = sw[6144 + c], bs = sb[c];
#pragma unroll
    for (int k = 0; k < CPT; ++k) {
      const int ch = tid + 256 * k, bq = ch / (L / 8), p0 = (ch % (L / 8)) * 8;
      const u16* s = UB + bq * UBS + p0;
      V8 rw; rw.u4 = raw[k];
      float x[10];
      x[0] = p0 > 0 ? bf2f(s[-1]) : 0.f;
#pragma unroll
      for (int e = 0; e < 8; ++e) x[e + 1] = bf2f(rw.h[e]);
      x[9] = p0 + 8 < L ? bf2f(s[8]) : 0.f;
      V8 o;
#pragma unroll
      for (int e = 0; e < 4; ++e)
        o.w[e] = pack2(w0 * x[2 * e] + w1 * x[2 * e + 1] + w2 * x[2 * e + 2] + bs,
                       w0 * x[2 * e + 1] + w1 * x[2 * e + 2] + w2 * x[2 * e + 3] + bs);
      raw[k] = o.u4;
    }
    __syncthreads();
#pragma unroll
    for (int k = 0; k < CPT; ++k) {
      const int ch = tid + 256 * k, bq = ch / (L / 8), p0 = (ch % (L / 8)) * 8;
      *(uint4*)(UB + bq * UBS + p0) = raw[k];
    }
  }
  const int ncol0 = w * 16 * NI;
  const int Imin = ncol0 / NB, Imax = (ncol0 + 16 * NI - 1) / NB;
  const int cp = (-l) & 3;
#pragma unroll 1
  for (int o = 0; o < 2; ++o) {
    const u16* hr = p.hrev + hrev_off(li, GRP, o, c);
    for (int g = tid; g < 2 * L / 8; g += 256) {
      uint4 A = *(const uint4*)(hr + 8 * g);
      uint4 B = make_uint4(0, 0, 0, 0);
      if (g + 1 < 2 * L / 8) B = *(const uint4*)(hr + 8 * g + 8);
      unsigned wd[8] = {A.x, A.y, A.z, A.w, B.x, B.y, B.z, B.w};
#pragma unroll
      for (int cq = 0; cq < 4; ++cq) {
        uint4 ov;
        unsigned t[4];
#pragma unroll
        for (int k = 0; k < 4; ++k)
          t[k] = (cq & 1) ? ((wd[k + cq / 2] >> 16) | (wd[k + cq / 2 + 1] << 16)) : wd[k + cq / 2];
        ov.x = t[0]; ov.y = t[1]; ov.z = t[2]; ov.w = t[3];
        *(uint4*)(HC + cq * HCS + 8 * g) = ov;
      }
    }
    __syncthreads();
    const int gch = (o + 1) * 1024 + c;
    uint4 xr0, xr1, xr2, xr3, xr4 = make_uint4(0, 0, 0, 0), xr5 = xr4, xr6 = xr4, xr7 = xr4;
    {
      const u16* xsrc = UT + (size_t)gch * TTOT + TOK0 + (size_t)tid * 8;
      xr0 = *(const uint4*)(xsrc); xr1 = *(const uint4*)(xsrc + 2048); xr2 = *(const uint4*)(xsrc + 4096); xr3 = *(const uint4*)(xsrc + 6144);
      if (CPT == 8) {
        xr4 = *(const uint4*)(xsrc + 8192); xr5 = *(const uint4*)(xsrc + 10240); xr6 = *(const uint4*)(xsrc + 12288); xr7 = *(const uint4*)(xsrc + 14336);
      }
    }
    f32x4 acc[4][NI];
#pragma unroll
    for (int mi = 0; mi < 4; ++mi)
#pragma unroll
      for (int ni = 0; ni < NI; ++ni) acc[mi][ni] = (f32x4){0.f, 0.f, 0.f, 0.f};
#pragma unroll 1
    for (int dd = Imin - (NIB - 1); dd <= Imax; ++dd) {
      bf16x8 fr[6];
#pragma unroll
      for (int e6 = 0; e6 < 6; ++e6) {
        const int x0 = L - 64 * dd + 16 * (e6 - 3) + 8 * q - l;
        const u16* a = HC + cp * HCS + (x0 - cp);
        V8 t;
        t.u2[0] = *(const uint2*)a;
        t.u2[1] = *(const uint2*)(a + 4);
        fr[e6] = t.v;
      }
#pragma unroll
      for (int ks = 0; ks < 2; ++ks) {
#pragma unroll
        for (int ni = 0; ni < NI; ++ni) {
          const int n = ncol0 + 16 * ni + l;
          const int I = n / NB, bb = n % NB;
          const int J = I - dd;
          V8 bfr; bfr.u4 = make_uint4(0, 0, 0, 0);
          if (J >= 0 && J < NIB) bfr.u4 = *(const uint4*)(UB + bb * UBS + 64 * J + 32 * ks + 8 * q);
#pragma unroll
          for (int mi = 0; mi < 4; ++mi) acc[mi][ni] = MFMA(fr[2 * ks - mi + 3], bfr.v, acc[mi][ni]);
        }
      }
    }
    __syncthreads();
    {
      u16* xd = XR + (size_t)tid * 8;
      *(uint4*)(xd) = xr0; *(uint4*)(xd + 2048) = xr1; *(uint4*)(xd + 4096) = xr2; *(uint4*)(xd + 6144) = xr3;
      if (CPT == 8) {
        *(uint4*)(xd + 8192) = xr4; *(uint4*)(xd + 10240) = xr5; *(uint4*)(xd + 12288) = xr6; *(uint4*)(xd + 14336) = xr7;
      }
    }
    __syncthreads();
    const float w0 = sw[gch], w1 = sw[3072 + gch], w2 = sw[6144 + gch], bs = sb[gch];
#pragma unroll
    for (int mi = 0; mi < 4; ++mi) {
#pragma unroll
      for (int ni = 0; ni < NI; ++ni) {
        const int n = ncol0 + 16 * ni + l;
        const int I = n / NB, bb = n % NB;
        const int pp = 64 * I + 16 * mi + 4 * q;
        const u16* s = XR + bb * L + pp;
        const uint2 raw = *(const uint2*)s;
        float x[6];
        x[0] = pp > 0 ? bf2f(s[-1]) : 0.f;
        x[1] = bflo(raw.x); x[2] = bfhi(raw.x); x[3] = bflo(raw.y); x[4] = bfhi(raw.y);
        x[5] = pp + 4 < L ? bf2f(s[4]) : 0.f;
        float z[4];
#pragma unroll
        for (int r = 0; r < 4; ++r) z[r] = (w0 * x[r] + w1 * x[r + 1] + w2 * x[r + 2] + bs) * acc[mi][ni][r];
        uint2 ov; ov.x = pack2(z[0], z[1]); ov.y = pack2(z[2], z[3]);
        *(uint2*)(UB + bb * UBS + pp) = ov;
      }
    }
    __syncthreads();
  }
  {
    u16* dst = Z2T + (size_t)c * TTOT + TOK0;
#pragma unroll
    for (int k = 0; k < CPT; ++k) {
      const int ch = tid + 256 * k, bq = ch / (L / 8), p0 = (ch % (L / 8)) * 8;
      *(uint4*)(dst + (size_t)ch * 8) = *(const uint4*)(UB + bq * UBS + p0);
    }
  }
}

__device__ void lrua_unit(const Params& p, int li, int u, char* smem) {
  u16* XC = (u16*)smem;
  const int tid = tid_opaque(), lane = tid & 63, w = tid >> 6, l = lane & 15, q = lane >> 4;
  const int tt = u >> 3, blk = u & 7, t0 = tt * 64;
  int L, sbase;
  if (t0 < TCTX) { L = 256; sbase = (t0 >> 8) << 8; }
  else { L = 2048; sbase = TCTX + (((t0 - TCTX) >> 11) << 11); }
  const int p0 = t0 - sbase;
  const u16* PR = p.R1 + (size_t)3072 * TTOT;
  u16* LA = p.R2; u16* BB = p.R3;
  __syncthreads();
  {
    const int cc = tid & 15, ch = blk * 128 + cc * 8;
    float wk[4][8], bias[8];
    {
      const float4 b0 = *(const float4*)(p.lru_conv_b + li * 1024 + ch), b1 = *(const float4*)(p.lru_conv_b + li * 1024 + ch + 4);
      bias[0] = b0.x; bias[1] = b0.y; bias[2] = b0.z; bias[3] = b0.w; bias[4] = b1.x; bias[5] = b1.y; bias[6] = b1.z; bias[7] = b1.w;
#pragma unroll
      for (int k = 0; k < 4; ++k) {
        const float* wp = p.lru_conv_w + (li * 4 + k) * 1024 + ch;
        const float4 w0 = *(const float4*)wp, w1 = *(const float4*)(wp + 4);
        wk[k][0] = w0.x; wk[k][1] = w0.y; wk[k][2] = w0.z; wk[k][3] = w0.w;
        wk[k][4] = w1.x; wk[k][5] = w1.y; wk[k][6] = w1.z; wk[k][7] = w1.w;
      }
    }
#pragma unroll 2
    for (int it = 0; it < 4; ++it) {
      const int row = (tid >> 4) + 16 * it;
      uint4 xr[4];
#pragma unroll
      for (int k = 0; k < 4; ++k) {
        const int pp = p0 + row + k - 2;
        xr[k] = (pp >= 0 && pp < L) ? *(const uint4*)(PR + (size_t)(sbase + pp) * 3072 + 1024 + ch) : make_uint4(0, 0, 0, 0);
      }
      float a8[8];
#pragma unroll
      for (int e = 0; e < 8; ++e) a8[e] = bias[e];
#pragma unroll
      for (int k = 0; k < 4; ++k) {
        V8 raw; raw.u4 = xr[k];
#pragma unroll
        for (int e = 0; e < 8; ++e) a8[e] += wk[k][e] * bf2f(raw.h[e]);
      }
      uint4 ov; ov.x = pack2(a8[0], a8[1]); ov.y = pack2(a8[2], a8[3]); ov.z = pack2(a8[4], a8[5]); ov.w = pack2(a8[6], a8[7]);
      *(uint4*)(XC + row * 136 + cc * 8) = ov;
    }
  }
  __syncthreads();
  u16* LAt = XC + 64 * 136;
  u16* BBt = LAt + 64 * 136;
#pragma unroll
  for (int dir = 0; dir < 2; ++dir) {
#pragma unroll
    for (int ni = 0; ni < 2; ++ni) {
      f32x4 ar[4], ai[4];
#pragma unroll
      for (int mi = 0; mi < 4; ++mi) { ar[mi] = (f32x4){0.f, 0.f, 0.f, 0.f}; ai[mi] = (f32x4){0.f, 0.f, 0.f, 0.f}; }
      const u16* wr = p.wlru + (size_t)((((li * 2 + dir) * 8 + blk) * 2) + 0) * 16384;
      const u16* wi = wr + 16384;
      const int nrow = 32 * w + 16 * ni + l;
#pragma unroll
      for (int ks = 0; ks < 4; ++ks) {
        bf16x8 br = *(const bf16x8*)(wr + nrow * 128 + 32 * ks + 8 * q);
        bf16x8 bi = *(const bf16x8*)(wi + nrow * 128 + 32 * ks + 8 * q);
#pragma unroll
        for (int mi = 0; mi < 4; ++mi) {
          bf16x8 a = *(const bf16x8*)(XC + (16 * mi + l) * 136 + 32 * ks + 8 * q);
          ar[mi] = MFMA(a, br, ar[mi]);
          ai[mi] = MFMA(a, bi, ai[mi]);
        }
      }
      const int chl = nrow, C = blk * 128 + chl;
      const float brv = p.lru_b_r[(li * 2 + dir) * 1024 + C], biv = p.lru_b_i[(li * 2 + dir) * 1024 + C];
      const float lam = p.lru_lambda[(li * 2 + dir) * 1024 + C];
      const float sp = log1pf(expf(-lam));
#pragma unroll
      for (int mi = 0; mi < 4; ++mi)
#pragma unroll
        for (int r = 0; r < 4; ++r) {
          const int row = 16 * mi + 4 * q + r;
          const float rr = sigmoidf_(ar[mi][r] + brv), ig = sigmoidf_(ai[mi][r] + biv);
          const float la = -8.f * rr * sp;
          const float e2 = __expf(2.f * la);
          const float om = la > -0.05f ? -2.f * la * (1.f + la * (1.f + la * (2.f / 3.f))) : 1.f - e2;
          const float bbv = __builtin_amdgcn_sqrtf(om) * ig * bf2f(XC[row * 136 + chl]);
          LAt[row * 136 + chl] = f2bf(la);
          BBt[row * 136 + chl] = f2bf(bbv);
        }
    }
    __syncthreads();
    {
      const int ch = tid & 127, hf = tid >> 7;
      float P = 1.f, Hh = 0.f;
#pragma unroll 8
      for (int s = 0; s < 32; ++s) {
        const int row = 32 * hf + (dir ? 31 - s : s);
        const float a = __expf(bf2f(LAt[row * 136 + ch]));
        Hh = a * Hh + bf2f(BBt[row * 136 + ch]);
        P *= a;
      }
      const size_t so = ((size_t)dir * (TTOT / 32) + (t0 >> 5) + hf) * 1024 + blk * 128 + ch;
      p.pseg[so] = P;
      p.hseg[so] = Hh;
    }
#pragma unroll
    for (int i = 0; i < 4; ++i) {
      const int id = tid + 256 * i, row = id >> 4, cc = id & 15;
      const size_t go = ((size_t)dir * TTOT + t0 + row) * 1024 + blk * 128 + cc * 8;
      *(uint4*)(LA + go) = *(const uint4*)(LAt + row * 136 + cc * 8);
      *(uint4*)(BB + go) = *(const uint4*)(BBt + row * 136 + cc * 8);
    }
    __syncthreads();
  }
}

template <int LOGCO>
__device__ void lrub_unit(const Params& p, int li, int u, char* smem) {
  constexpr int NCO = 1 << LOGCO, NSEG = 256 >> LOGCO, CW = 8 * NCO;
  float* PS = (float*)smem;
  float* HS = PS + 2048;
  const int tid = tid_opaque();
  const int co = tid & (NCO - 1), seg = tid >> LOGCO;
  int b, L, base, cg_;
  bool latent;
  if (LOGCO == 2) { latent = true; b = u >> 5; cg_ = u & 31; L = 2048; base = TCTX + b * 2048; }
  else { latent = false; b = u >> 2; cg_ = u & 3; L = 256; base = b * 256; }
  const int C0 = cg_ * CW + co * 8;
  const int SL = L / NSEG;
  const u16* LA = p.R2; const u16* BB = p.R3;
  const u16* PR = p.R1 + (size_t)3072 * TTOT;
  u16* Y = p.R1;
#pragma unroll
  for (int dir = 0; dir < 2; ++dir) {
    const u16* la_ = LA + (size_t)dir * TTOT * 1024 + C0;
    const u16* bb_ = BB + (size_t)dir * TTOT * 1024 + C0;
    __syncthreads();
    {
      const int tseg = dir ? NSEG - 1 - seg : seg;
      const size_t so = ((size_t)dir * (TTOT / 32) + (base >> 5) + tseg) * 1024 + C0;
      *(float4*)(PS + seg * CW + co * 8) = *(const float4*)(p.pseg + so);
      *(float4*)(PS + seg * CW + co * 8 + 4) = *(const float4*)(p.pseg + so + 4);
      *(float4*)(HS + seg * CW + co * 8) = *(const float4*)(p.hseg + so);
      *(float4*)(HS + seg * CW + co * 8 + 4) = *(const float4*)(p.hseg + so + 4);
    }
    __syncthreads();
    float h[8];
    if (latent) {
      const float* sp_ = p.state_lru + ((b * 2 + li) * 2 + dir) * 1024 + C0;
      float4 s0 = *(const float4*)sp_, s1 = *(const float4*)(sp_ + 4);
      h[0] = s0.x; h[1] = s0.y; h[2] = s0.z; h[3] = s0.w; h[4] = s1.x; h[5] = s1.y; h[6] = s1.z; h[7] = s1.w;
    } else {
#pragma unroll
      for (int e = 0; e < 8; ++e) h[e] = 0.f;
    }
    for (int s2 = 0; s2 < seg; ++s2) {
      float4 p0 = *(const float4*)(PS + s2 * CW + co * 8), p1 = *(const float4*)(PS + s2 * CW + co * 8 + 4);
      float4 q0 = *(const float4*)(HS + s2 * CW + co * 8), q1 = *(const float4*)(HS + s2 * CW + co * 8 + 4);
      h[0] = p0.x * h[0] + q0.x; h[1] = p0.y * h[1] + q0.y; h[2] = p0.z * h[2] + q0.z; h[3] = p0.w * h[3] + q0.w;
      h[4] = p1.x * h[4] + q1.x; h[5] = p1.y * h[5] + q1.y; h[6] = p1.z * h[6] + q1.z; h[7] = p1.w * h[7] + q1.w;
    }
#pragma unroll 4
    for (int s = 0; s < SL; ++s) {
      const int pos = dir ? L - 1 - (seg * SL + s) : seg * SL + s;
      const int tkn = base + pos;
      const size_t off = (size_t)tkn * 1024;
      V8 la, bb; la.u4 = *(const uint4*)(la_ + off); bb.u4 = *(const uint4*)(bb_ + off);
#pragma unroll
      for (int e = 0; e < 8; ++e) h[e] = __expf(bf2f(la.h[e])) * h[e] + bf2f(bb.h[e]);
      u16* yp = Y + (size_t)tkn * 2048 + 1024 + C0;
      V8 o;
      if (dir == 0) {
#pragma unroll
        for (int e = 0; e < 4; ++e) o.w[e] = pack2(h[2 * e], h[2 * e + 1]);
      } else {
        V8 hf, zr; hf.u4 = *(const uint4*)yp; zr.u4 = *(const uint4*)(PR + (size_t)tkn * 3072 + 2048 + C0);
#pragma unroll
        for (int e = 0; e < 4; ++e)
          o.w[e] = pack2((bf2f(hf.h[2 * e]) + h[2 * e]) * siluf_(bf2f(zr.h[2 * e])),
                         (bf2f(hf.h[2 * e + 1]) + h[2 * e + 1]) * siluf_(bf2f(zr.h[2 * e + 1])));
      }
      *(uint4*)yp = o.u4;
    }
    if (!latent && seg == NSEG - 1) {
      float* so = p.out + OFF_LRU + ((b * 2 + li) * 2 + dir) * 1024 + C0;
      *(float4*)so = make_float4(h[0], h[1], h[2], h[3]);
      *(float4*)(so + 4) = make_float4(h[4], h[5], h[6], h[7]);
    }
  }
}

__device__ void c2_trans_unit(const Params& p, int u, char* smem) {
  u16* tile = (u16*)smem;
  const int tid = tid_opaque();
  const int tt = u >> 4, ct = u & 15, t0 = tt * 64, c0 = ct * 64;
  const u16* Z2T = p.H;
  const u16* PR = p.R1 + (size_t)3072 * TTOT;
  u16* Y = p.R1;
  __syncthreads();
  {
    const int r = tid >> 2, part = tid & 3;
    const u16* s = Z2T + (size_t)(c0 + r) * TTOT + t0 + part * 16;
    *(uint4*)(tile + r * 72 + part * 16) = *(const uint4*)s;
    *(uint4*)(tile + r * 72 + part * 16 + 8) = *(const uint4*)(s + 8);
  }
  __syncthreads();
  {
    const int t = tid >> 2, cpart = tid & 3;
    const u16* zp = PR + (size_t)(t0 + t) * 3072 + c0 + cpart * 16;
    V8 z0, z1; z0.u4 = *(const uint4*)zp; z1.u4 = *(const uint4*)(zp + 8);
    V8 o0, o1;
#pragma unroll
    for (int e = 0; e < 8; ++e) {
      o0.h[e] = f2bf(bf2f(tile[(cpart * 16 + e) * 72 + t]) * siluf_(bf2f(z0.h[e])));
      o1.h[e] = f2bf(bf2f(tile[(cpart * 16 + 8 + e) * 72 + t]) * siluf_(bf2f(z1.h[e])));
    }
    u16* yp = Y + (size_t)(t0 + t) * 2048 + c0 + cpart * 16;
    *(uint4*)yp = o0.u4;
    *(uint4*)(yp + 8) = o1.u4;
  }
}

__global__ void __launch_bounds__(256, 2) mega(Params p, int ph0, int ph1) {
  extern __shared__ __attribute__((aligned(16))) char smem[];
  __shared__ uint4 xb_words;
  cg::grid_group grid = cg::this_grid();
  if (threadIdx.x == 0) xb_words = make_uint4(0u, 0u, 0u, 0u);
  __syncthreads();
  XcdBarrier xb = xcd_barrier_post(p.bar, (volatile LAS unsigned*)&xb_words);
  const int vb = blockIdx.x, G = gridDim.x;
  for (int ph = ph0; ph < ph1; ++ph) {
    if (ph == 0) {
      for (int u = vb; u < 10048; u += G) {
        if (u < 1152) p0_hyf(p, u, smem);
        else if (u < 1536) p0_mod(p, u - 1152, smem);
        else p0_trans(p, u - 1536, smem);
      }
    } else if (ph == NPHASE - 1) {
      final_norm(p, vb, G);
    } else {
      const int layer = (ph - 1) / 5, sub = (ph - 1) % 5, li = layer >> 1;
      const bool ab = (layer & 1) == 0;
      const float* xp = layer == 0 ? p.x_prompt : p.out;
      const float* xs = layer == 0 ? p.x_sample : p.out + (size_t)TCTX * 1024;
      if (sub == 0) {
        norm_rows(p, layer, xp, xs, vb, G);
      } else if (sub == 1) {
        if (ab) {
          const u16* Bt = p.wab_in + (size_t)li * NPAB * 1024;
          for (int i = 0;; ++i) {
            const int seq = (i * 8 + (vb & 7)) * (G >> 3) + (vb >> 3);
            if (seq >= 96 * 48) break;
            const int panel = seq / (8 * 48), rem = seq - panel * (8 * 48);
            gemm_big<0>(p, p.H, Bt, (panel * 8 + ((rem >> 3) & 7)) * 256, ((rem >> 6) * 8 + (rem & 7)) * 128, smem);
          }
          for (int t = vb; t < 96; t += G) gemm_thin(p, p.H, Bt, t * 256, smem);
        } else {
          const u16* Bt = p.wcd_in + (size_t)li * 6144 * 1024;
          for (int i = 0;; ++i) {
            const int seq = (i * 8 + (vb & 7)) * (G >> 3) + (vb >> 3);
            if (seq >= 96 * 48) break;
            const int panel = seq / (8 * 48), rem = seq - panel * (8 * 48);
            gemm_big<1>(p, p.H, Bt, (panel * 8 + ((rem >> 3) & 7)) * 256, ((rem >> 6) * 8 + (rem & 7)) * 128, smem);
          }
        }
      } else if (sub == 2) {
        if (ab) {
          for (int u = vb; u < 2560; u += G) {
            const int r = u % G, base = u - r;
            const int v = G == 512 ? base + 64 * (r & 7) + (r >> 3) : u;
            gla_unit(p, li, v < 512 ? v : 512 + ((v - 512) ^ 32), smem);
          }
        } else {
          const int nk_ = (5120 - vb + G - 1) / G;
          for (int k_ = 0; k_ < nk_; ++k_) {
            const int u = vb + (((vb >> 3) & 1) ? nk_ - 1 - k_ : k_) * G;
            if (u < 1024) conv_unit<1>(p, li, u, smem);
            else if (u < 2048) conv_unit<0>(p, li, u - 1024, smem);
            else lrua_unit(p, li, u - 2048, smem);
          }
        }
      } else if (sub == 3) {
        if (ab) headnorm_rows(p, li, vb, G);
        else {
          for (int u = vb; u < 384 + 6144; u += G) {
            if (u < 256) lrub_unit<2>(p, li, u, smem);
            else if (u < 384) lrub_unit<5>(p, li, u - 256, smem);
            else c2_trans_unit(p, u - 384, smem);
          }
        }
      } else {
        const u16* A = ab ? p.R2 : p.R1;
        const u16* Bt = (ab ? p.wab_out : p.wcd_out) + (size_t)li * 1024 * 2048;
        if (G == 512) {
          const int seq = (vb & 7) * 64 + (vb >> 3);
          const int panel = seq >> 6, rem = seq & 63;
          gemm_big<2>(p, A, Bt, (panel * 8 + (rem >> 3)) * 256, (rem & 7) * 128, smem, 2048, layer, xp, xs);
          gemm_tile<2>(p, A, 2048, Bt, 2048, 16384 + (panel * 8 + (rem >> 3)) * 128, (rem & 7) * 128, layer, xp, xs, smem, p.out);
        } else {
          for (int i = 0;; ++i) {
            const int seq = (i * 8 + (vb & 7)) * (G >> 3) + (vb >> 3);
            if (seq >= 192 * 8) break;
            const int panel = seq / 64, rem = seq - panel * 64;
            gemm_tile<2>(p, A, 2048, Bt, 2048, (panel * 8 + (rem & 7)) * 128, (rem >> 3) * 128, layer, xp, xs, smem, p.out);
          }
        }
      }
    }
    if (ph + 1 < ph1) {
      if (ph1 > NPHASE) grid.sync();
      xcd_barrier(xb);
    }
  }
}

extern "C" void kernel_launch(void* const* d_in, const int* in_sizes, int n_in, void* d_out, int out_size, void* d_ws,
                              size_t ws_size, hipStream_t stream) {
  static int grid_blocks = 0;
  if (!grid_blocks) {
    int dev = 0, cus = 0, per_cu = 0;
    hipGetDevice(&dev);
    hipDeviceGetAttribute(&cus, hipDeviceAttributeMultiprocessorCount, dev);
    hipFuncSetAttribute((const void*)mega, hipFuncAttributeMaxDynamicSharedMemorySize, SMEM_BYTES);
    hipOccupancyMaxActiveBlocksPerMultiprocessor(&per_cu, mega, 256, SMEM_BYTES);
    if (per_cu > 2) per_cu = 2;
    if (per_cu < 1) per_cu = 1;
    grid_blocks = cus * per_cu;
  }
  Params p{};
  const float** pf = (const float**)&p;
  for (int i = 0; i < 36; ++i) pf[i] = (const float*)d_in[i];
  p.out = (float*)d_out;
  char* ws = (char*)d_ws;
  size_t off = 0;
  auto take = [&](size_t bytes) { char* r = ws + off; off += (bytes + 255) & ~(size_t)255; return r; };
  p.mod = (float*)take((size_t)4 * 9 * 3072 * 4);
  p.ga32 = (float*)take((size_t)TTOT * 32 * 4);
  p.wab_in = (u16*)take((size_t)2 * NPAB * 1024 * 2);
  p.wab_out = (u16*)take((size_t)2 * 1024 * 2048 * 2);
  p.wcd_in = (u16*)take((size_t)2 * 6144 * 1024 * 2);
  p.wcd_out = (u16*)take((size_t)2 * 1024 * 2048 * 2);
  p.wlru = (u16*)take((size_t)64 * 16384 * 2);
  p.hrev = (u16*)take((size_t)2 * 9437184 * 2);
  p.H = (u16*)take((size_t)TTOT * 1024 * 2);
  p.R1 = (u16*)take((size_t)TTOT * NPAB * 2);
  p.R2 = (u16*)take((size_t)TTOT * 2048 * 2);
  p.R3 = (u16*)take((size_t)TTOT * 2048 * 2);
  p.bar = (unsigned*)take((size_t)XCD_BAR_WORDS * 4);
  hipMemsetAsync(p.bar, 0, (size_t)XCD_BAR_WORDS * 4, stream);
  p.pseg = (float*)take((size_t)2 * (TTOT / 32) * 1024 * 4);
  p.hseg = (float*)take((size_t)2 * (TTOT / 32) * 1024 * 4);
  int ph0 = 0, ph1 = NPHASE;
#ifdef MULTI
  for (int ph = 0; ph < NPHASE; ++ph) {
    ph0 = ph; ph1 = ph + 1;
    void* args[] = {&p, &ph0, &ph1};
    hipLaunchCooperativeKernel((void*)mega, dim3(grid_blocks), dim3(256), args, SMEM_BYTES, stream);
  }
#else
  void* args[] = {&p, &ph0, &ph1};
  hipError_t e = hipLaunchCooperativeKernel((void*)mega, dim3(grid_blocks), dim3(256), args, SMEM_BYTES, stream);
  if (e != hipSuccess) fprintf(stderr, "cooperative launch failed: %s (grid %d)\n", hipGetErrorString(e), grid_blocks);
#endif
}
```

```cpp
#include <hip/hip_runtime.h>
#include <hip/hip_cooperative_groups.h>
#include <cstdio>
namespace cg = cooperative_groups;

typedef unsigned short u16;
using bf16x8 = __attribute__((ext_vector_type(8))) short;
using f32x4 = __attribute__((ext_vector_type(4))) float;
union V8 { bf16x8 v; uint4 u4; uint2 u2[2]; unsigned w[4]; u16 h[8]; };

#define TTOT 24576
#define TCTX 8192
#define NPAB 6272
#define OFF_GLA 25165824
#define OFF_RET 41943040
#define OFF_LRU 58720256
#define SMEM_BYTES 77824
#define NPHASE 22

struct Params {
  const float *x_prompt, *x_sample, *c, *state_gla, *state_ret, *state_lru, *c_ctx, *norm_g, *w_mod, *b_mod,
      *ab_w_in, *ab_gate_w2, *ab_gate_b, *ab_head_g, *ab_w_out, *cd_w_in, *hy_short_w, *hy_short_b,
      *hy_w1, *hy_b1, *hy_freq1, *hy_w2, *hy_b2, *hy_freq2, *hy_w3, *hy_b3, *hy_skip, *lru_conv_w,
      *lru_conv_b, *lru_w_r, *lru_b_r, *lru_w_i, *lru_b_i, *lru_lambda, *cd_w_out, *final_g;
  float* out;
  float* mod;
  float* ga32;
  u16 *wab_in, *wab_out, *wcd_in, *wcd_out, *wlru, *hrev, *H, *R1, *R2, *R3;
  unsigned* bar;
  float *pseg, *hseg;
};

typedef __bf16 bf2_t __attribute__((ext_vector_type(2)));
typedef float f2_t __attribute__((ext_vector_type(2)));
__device__ __forceinline__ unsigned pack2(float a, float b) {
  f2_t v = {a, b};
  return __builtin_bit_cast(unsigned, __builtin_convertvector(v, bf2_t));
}
__device__ __forceinline__ u16 f2bf(float f) { return (u16)(pack2(f, f) & 0xffffu); }
__device__ __forceinline__ float bf2f(u16 h) { return __uint_as_float(((unsigned)h) << 16); }
__device__ __forceinline__ float bflo(unsigned w) { return __uint_as_float(w << 16); }
__device__ __forceinline__ float bfhi(unsigned w) { return __uint_as_float(w & 0xffff0000u); }
__device__ __forceinline__ int cidx_of(int t) { return t < TCTX ? 0 : 1 + ((t - TCTX) >> 11); }
__device__ __forceinline__ float wave_sum(float v) {
#pragma unroll
  for (int off = 32; off > 0; off >>= 1) v += __shfl_xor(v, off);
  return v;
}
__device__ __forceinline__ float sigmoidf_(float x) { return __builtin_amdgcn_rcpf(1.f + __expf(-x)); }
__device__ __forceinline__ float siluf_(float x) { return x * __builtin_amdgcn_rcpf(1.f + __expf(-x)); }
__device__ __forceinline__ int tid_opaque() { int t = threadIdx.x; asm volatile("" : "+v"(t)); return t; }
typedef __attribute__((address_space(3))) void* lds_ptr_t;
typedef const __attribute__((address_space(1))) void* gbl_ptr_t;
#define MFMA(a, b, c) __builtin_amdgcn_mfma_f32_16x16x32_bf16((a), (b), (c), 0, 0, 0)

__device__ __forceinline__ size_t hrev_off(int li, int grp, int o, int c) {
  size_t base = (size_t)li * 9437184u;
  if (grp == 0) return base + (size_t)(o * 1024 + c) * 512;
  return base + 1048576u + (size_t)(o * 1024 + c) * 4096;
}


#define XB_TMO      128
#define XB_XCNT(j)  (256  + 64 * (j))
#define XB_XSUB(j)  (1280 + 64 * (j))
#define XB_XGEN(j)  (2304 + 64 * (j))
#define XB_TOP      3328
#define XB_TOPGEN   3392
#define XCD_BAR_WORDS 3456
#define XB_SPIN_CAP (1u << 20)
#define LAS __attribute__((address_space(3)))
__device__ __forceinline__ unsigned xb_ld(unsigned* p) { return __hip_atomic_load(p, __ATOMIC_RELAXED, __HIP_MEMORY_SCOPE_AGENT); }
__device__ __forceinline__ unsigned xb_add(unsigned* p, unsigned v) { return __hip_atomic_fetch_add(p, v, __ATOMIC_RELAXED, __HIP_MEMORY_SCOPE_AGENT); }
__device__ __forceinline__ unsigned xb_xcc_id() { return (unsigned)__builtin_amdgcn_s_getreg((3 << 11) | 20) & 0xFu; }
#define XB_SPIN(cond, bar) do { unsigned _sp = 0; while (cond) { __builtin_amdgcn_s_sleep(1); \
    if ((++_sp & 255u) == 0u) { if (xb_ld(&(bar)[XB_TMO])) break; if (_sp > XB_SPIN_CAP) { atomicAdd(&(bar)[XB_TMO], 1u); break; } } } } while (0)
struct XcdBarrier { unsigned* bar; unsigned x; volatile LAS unsigned* st; };
__device__ __forceinline__ XcdBarrier xcd_barrier_post(unsigned* bar, volatile LAS unsigned* st) {
  XcdBarrier b; b.bar = bar; b.x = xb_xcc_id(); b.st = st;
  if (threadIdx.x == 0) (void)xb_add(&bar[XB_XCNT(b.x)], 1u);
  return b;
}
__device__ __forceinline__ void xcd_barrier_complete(unsigned* bar, unsigned x, unsigned& nloc, unsigned& nx) {
  const unsigned G = gridDim.x * gridDim.y * gridDim.z;
  unsigned sum, cnt, mine, sp = 0u;
  for (;;) {
    sum = 0u; cnt = 0u; mine = 0u;
#pragma unroll
    for (unsigned j = 0; j < 16; ++j) { const unsigned c = xb_ld(&bar[XB_XCNT(j)]); sum += c; cnt += (c > 0u) ? 1u : 0u; mine = (j == x) ? c : mine; }
    if (sum == G) break;
    __builtin_amdgcn_s_sleep(1);
    if ((++sp & 255u) == 0u) { if (xb_ld(&bar[XB_TMO])) break; if (sp > XB_SPIN_CAP) { atomicAdd(&bar[XB_TMO], 1u); break; } }
  }
  nloc = mine > 0u ? mine : 1u; nx = cnt > 0u ? cnt : 1u;
}
__device__ __forceinline__ void xcd_barrier(const XcdBarrier& b) {
  asm volatile("s_waitcnt vmcnt(0)" ::: "memory");
  __syncthreads();
  if (threadIdx.x == 0) {
    unsigned* bar = b.bar;
    __builtin_amdgcn_s_waitcnt(0);
    unsigned nloc = b.st[0], nx = b.st[1];
    if (nloc == 0u) { xcd_barrier_complete(bar, b.x, nloc, nx); b.st[0] = nloc; b.st[1] = nx; }
    const unsigned old = xb_add(&bar[XB_XSUB(b.x)], 1u);
    const unsigned gen = old / nloc;
    if (old + 1u == (gen + 1u) * nloc) {
      __builtin_amdgcn_fence(__ATOMIC_RELEASE, "agent");
      asm volatile("s_waitcnt vmcnt(0)" ::: "memory");
      const unsigned og = xb_add(&bar[XB_TOP], 1u);
      const unsigned tg = og / nx;
      if (og + 1u == (tg + 1u) * nx) xb_add(&bar[XB_TOPGEN], 1u);
      else XB_SPIN(xb_ld(&bar[XB_TOPGEN]) == tg, bar);
      __builtin_amdgcn_fence(__ATOMIC_ACQUIRE, "agent");
      xb_add(&bar[XB_XGEN(b.x)], 1u);
      asm volatile("s_waitcnt vmcnt(0)" ::: "memory");
    } else {
      XB_SPIN(xb_ld(&bar[XB_XGEN(b.x)]) == gen, bar);
      __builtin_amdgcn_fence(__ATOMIC_ACQUIRE, "agent");
      asm volatile("s_waitcnt vmcnt(0)" ::: "memory");
    }
  }
  __syncthreads();
}

__device__ void p0_mod(const Params& p, int u, char* smem) {
  float* sc = (float*)smem;
  float* red = sc + 9 * 1024;
  const int tid = tid_opaque();
  const int layer = u / 96, col0 = (u % 96) * 32;
  __syncthreads();
#pragma unroll 1
  for (int i0 = 0; i0 < 36; i0 += 9) {
    float v[9];
#pragma unroll
    for (int i = 0; i < 9; ++i) {
      const int idx = tid + 256 * (i0 + i), ci = idx >> 10, k = idx & 1023;
      v[i] = ci == 0 ? p.c_ctx[k] : p.c[(ci - 1) * 1024 + k];
    }
#pragma unroll
    for (int i = 0; i < 9; ++i) sc[tid + 256 * (i0 + i)] = v[i] * __builtin_amdgcn_rcpf(1.f + __expf(-v[i]));
  }
  __syncthreads();
  const int col = tid & 31, kg = tid >> 5;
  float acc[9];
#pragma unroll
  for (int ci = 0; ci < 9; ++ci) acc[ci] = 0.f;
  const float* wp = p.w_mod + (size_t)layer * 1024 * 3072 + col0 + col;
#pragma unroll 1
  for (int k0 = kg * 128; k0 < kg * 128 + 128; k0 += 16) {
    float wv[16];
#pragma unroll
    for (int i = 0; i < 16; ++i) wv[i] = wp[(size_t)(k0 + i) * 3072];
#pragma unroll
    for (int i = 0; i < 16; ++i)
#pragma unroll
      for (int ci = 0; ci < 9; ++ci) acc[ci] += sc[ci * 1024 + k0 + i] * wv[i];
  }
#pragma unroll
  for (int ci = 0; ci < 9; ++ci) red[(kg * 9 + ci) * 32 + col] = acc[ci];
  __syncthreads();
  for (int idx = tid; idx < 288; idx += 256) {
    int ci = idx >> 5, cc = idx & 31;
    float v = p.b_mod[layer * 3072 + col0 + cc];
#pragma unroll
    for (int g = 0; g < 8; ++g) v += red[(g * 9 + ci) * 32 + cc];
    p.mod[(layer * 9 + ci) * 3072 + col0 + cc] = v;
  }
}

__device__ void p0_trans_tile(const float* __restrict__ src, int N, u16* __restrict__ dst, int K, int k0, int n0,
                              char* smem) {
  float* tile = (float*)smem;
  const int tid = tid_opaque();
  __syncthreads();
  {
    float4 v[4];
#pragma unroll
    for (int i = 0; i < 4; ++i) {
      const int id = tid + 256 * i, kk = id >> 4, c4 = id & 15;
      const int n = n0 + c4 * 4;
      v[i] = n < N ? *(const float4*)(src + (size_t)(k0 + kk) * N + n) : make_float4(0.f, 0.f, 0.f, 0.f);
    }
#pragma unroll
    for (int i = 0; i < 4; ++i) {
      const int id = tid + 256 * i, kk = id >> 4, c4 = id & 15;
      float* t = tile + kk * 65 + c4 * 4;
      t[0] = v[i].x; t[1] = v[i].y; t[2] = v[i].z; t[3] = v[i].w;
    }
  }
  __syncthreads();
#pragma unroll
  for (int i = 0; i < 2; ++i) {
    const int id = tid + 256 * i, nn = id >> 3, kc = id & 7;
    const float* t = tile + (kc * 8) * 65 + nn;
    uint4 o;
    o.x = pack2(t[0], t[65]); o.y = pack2(t[130], t[195]); o.z = pack2(t[260], t[325]); o.w = pack2(t[390], t[455]);
    *(uint4*)(dst + (size_t)(n0 + nn) * K + k0 + kc * 8) = o;
  }
}

__device__ void p0_trans(const Params& p, int u, char* smem) {
  if (u < 3136) {
    int lay = u / 1568, r = u % 1568, kt = r / 98, nt = r % 98;
    p0_trans_tile(p.ab_w_in + (size_t)lay * 1024 * 6176, 6176, p.wab_in + (size_t)lay * NPAB * 1024, 1024, kt * 64,
                  nt * 64, smem);
  } else if (u < 4160) {
    int v = u - 3136, lay = v / 512, r = v % 512, kt = r / 16, nt = r % 16;
    p0_trans_tile(p.ab_w_out + (size_t)lay * 2048 * 1024, 1024, p.wab_out + (size_t)lay * 1024 * 2048, 2048, kt * 64,
                  nt * 64, smem);
  } else if (u < 7232) {
    int v = u - 4160, lay = v / 1536, r = v % 1536, kt = r / 96, nt = r % 96;
    p0_trans_tile(p.cd_w_in + (size_t)lay * 1024 * 6144, 6144, p.wcd_in + (size_t)lay * 6144 * 1024, 1024, kt * 64,
                  nt * 64, smem);
  } else if (u < 8256) {
    int v = u - 7232, lay = v / 512, r = v % 512, kt = r / 16, nt = r % 16;
    p0_trans_tile(p.cd_w_out + (size_t)lay * 2048 * 1024, 1024, p.wcd_out + (size_t)lay * 1024 * 2048, 2048, kt * 64,
                  nt * 64, smem);
  } else {
    int v = u - 8256, ri = v / 128, r = v % 128, mat = r / 4, t4 = r % 4, kt = t4 / 2, nt = t4 % 2;
    p0_trans_tile((ri ? p.lru_w_i : p.lru_w_r) + (size_t)mat * 16384, 128, p.wlru + (size_t)(mat * 2 + ri) * 16384,
                  128, kt * 64, nt * 64, smem);
  }
}

__device__ void p0_hyf(const Params& p, int u, char* smem) {
  float* g1s = (float*)smem;
  float* g2s = g1s + 4096;
  float* fts = g2s + 4096;
  const int tid = tid_opaque();
  const int li = u / 576;
  int r = u % 576, grp, ptile, ctile;
  if (r < 64) { grp = 0; ptile = r / 16; ctile = r % 16; }
  else { grp = 1; r -= 64; ptile = r / 16; ctile = r % 16; }
  const int L = grp ? 2048 : 256;
  const int pl = tid & 63;
  const int hg = __builtin_amdgcn_readfirstlane(tid >> 6);
  const int pg = ptile * 64 + pl;
  const float tpos = (float)pg / (float)(L - 1);
  __syncthreads();
  for (int f = hg; f < 33; f += 4) {
    float v;
    if (f == 0) v = tpos;
    else {
      const int bi = (f - 1) & 15;
      const float fb = 1e-4f + (float)bi * ((15.f - 1e-4f) / 15.f);
      float turns = (float)pg * fb * (1.f / (float)L);
      turns -= floorf(turns);
      const float ang = 6.283185307179586f * turns;
      v = f <= 16 ? __cosf(ang) : -__sinf(ang);
    }
    fts[f * 64 + pl] = v;
  }
  __syncthreads();
#pragma unroll 1
  for (int hh = 0; hh < 16; ++hh) {
    const int h = hg * 16 + hh;
    float s = p.hy_b1[li * 64 + h];
#pragma unroll 11
    for (int f = 0; f < 33; ++f) s += fts[f * 64 + pl] * p.hy_w1[(li * 33 + f) * 64 + h];
    g1s[h * 64 + pl] = __sinf(p.hy_freq1[li * 64 + h] * s);
  }
  __syncthreads();
#pragma unroll 1
  for (int hh = 0; hh < 16; ++hh) {
    const int h2 = hg * 16 + hh;
    float s = p.hy_b2[li * 64 + h2];
#pragma unroll 16
    for (int h = 0; h < 64; ++h) s += g1s[h * 64 + pl] * p.hy_w2[(li * 64 + h) * 64 + h2];
    g2s[h2 * 64 + pl] = __sinf(p.hy_freq2[li * 64 + h2] * s);
  }
  __syncthreads();
  float center[16];
#pragma unroll
  for (int cc = 0; cc < 16; ++cc) center[cc] = 0.f;
  const float A0 = -15.350567286626973f, A1 = -3.0701134573253945f;
#pragma unroll 1
  for (int f = 0; f < 4; ++f) {
    const int cb = f * 1024 + ctile * 64 + hg * 16;
    float a16[16];
#pragma unroll
    for (int cc = 0; cc < 16; ++cc) a16[cc] = p.hy_b3[li * 4096 + cb + cc];
    const float* w3 = p.hy_w3 + (size_t)li * 64 * 4096 + cb;
#pragma unroll 4
    for (int j = 0; j < 64; ++j) {
      const float g = g2s[j * 64 + pl];
#pragma unroll
      for (int cc = 0; cc < 16; ++cc) a16[cc] += g * w3[(size_t)j * 4096 + cc];
    }
    const int o = f >> 1;
#pragma unroll
    for (int cc = 0; cc < 16; ++cc) {
      const int c = ctile * 64 + hg * 16 + cc;
      const float delta = fabsf(A0 + (float)c * ((A1 - A0) / 1023.f));
      const float val = a16[cc] * __expf(-tpos * delta);
      u16* hr = p.hrev + hrev_off(li, grp, o, c);
      if (!(f & 1)) {
        if (pg == 0) { center[cc] = val; hr[0] = 0; }
        else hr[L - pg] = f2bf(val);
      } else {
        if (pg == 0) hr[L] = f2bf(center[cc] + val + p.hy_skip[(li * 2 + o) * 1024 + c]);
        else hr[L + pg] = f2bf(val);
      }
    }
  }
}

__device__ void norm_rows(const Params& p, int layer, const float* xp, const float* xs, int vb, int G) {
  const int tid_ = tid_opaque(); const int wave = tid_ >> 6, lane = tid_ & 63;
  for (int row = vb * 4 + wave; row < TTOT; row += G * 4) {
    const float* xr = row < TCTX ? xp + (size_t)row * 1024 : xs + (size_t)(row - TCTX) * 1024;
    float4 v[4];
    float ss = 0.f;
#pragma unroll
    for (int j = 0; j < 4; ++j) {
      v[j] = *(const float4*)(xr + j * 256 + lane * 4);
      ss += v[j].x * v[j].x + v[j].y * v[j].y + v[j].z * v[j].z + v[j].w * v[j].w;
    }
    ss = wave_sum(ss);
    const float rstd = rsqrtf(ss * (1.f / 1024.f) + 1e-6f);
    const float* md = p.mod + (size_t)(layer * 9 + cidx_of(row)) * 3072;
    const float* g = p.norm_g + layer * 1024;
#pragma unroll
    for (int j = 0; j < 4; ++j) {
      int col = j * 256 + lane * 4;
      float4 gg = *(const float4*)(g + col), sh = *(const float4*)(md + col), sl = *(const float4*)(md + 1024 + col);
      float h0 = v[j].x * rstd * gg.x * (1.f + sl.x) + sh.x;
      float h1 = v[j].y * rstd * gg.y * (1.f + sl.y) + sh.y;
      float h2 = v[j].z * rstd * gg.z * (1.f + sl.z) + sh.z;
      float h3 = v[j].w * rstd * gg.w * (1.f + sl.w) + sh.w;
      uint2 o; o.x = pack2(h0, h1); o.y = pack2(h2, h3);
      *(uint2*)(p.H + (size_t)row * 1024 + col) = o;
    }
  }
}

__device__ void final_norm(const Params& p, int vb, int G) {
  const int tid_ = tid_opaque(); const int wave = tid_ >> 6, lane = tid_ & 63;
  for (int row = vb * 4 + wave; row < TTOT; row += G * 4) {
    float* xr = p.out + (size_t)row * 1024;
    float4 v[4];
    float ss = 0.f;
#pragma unroll
    for (int j = 0; j < 4; ++j) {
      v[j] = *(const float4*)(xr + j * 256 + lane * 4);
      ss += v[j].x * v[j].x + v[j].y * v[j].y + v[j].z * v[j].z + v[j].w * v[j].w;
    }
    ss = wave_sum(ss);
    const float rstd = rsqrtf(ss * (1.f / 1024.f) + 1e-6f);
#pragma unroll
    for (int j = 0; j < 4; ++j) {
      int col = j * 256 + lane * 4;
      float4 gg = *(const float4*)(p.final_g + col);
      float4 o;
      o.x = v[j].x * rstd * gg.x; o.y = v[j].y * rstd * gg.y; o.z = v[j].z * rstd * gg.z; o.w = v[j].w * rstd * gg.w;
      *(float4*)(xr + col) = o;
    }
  }
}

__device__ void headnorm_rows(const Params& p, int li, int vb, int G) {
  const int tid_ = tid_opaque(); const int wave = tid_ >> 6, lane = tid_ & 63;
  u16* OF = p.R2; const u16* OB = p.R3; const u16* PROJ = p.R1;
  const int stride = G * 4;
  for (int item0 = vb * 4 + wave; item0 < TTOT * 8; item0 += 4 * stride) {
    uint2 a[4], b[4], z[4];
#pragma unroll
    for (int k = 0; k < 4; ++k) {
      const int item = item0 + k * stride;
      if (item < TTOT * 8) {
        const int t = item >> 3, hh = item & 7;
        const int col0 = hh * 256 + lane * 4;
        const int zc = (hh < 4 ? 2080 + hh * 256 : 5152 + (hh - 4) * 256) + lane * 4;
        a[k] = *(const uint2*)(OF + (size_t)t * 2048 + col0);
        b[k] = *(const uint2*)(OB + (size_t)t * 2048 + col0);
        z[k] = *(const uint2*)(PROJ + (size_t)t * NPAB + zc);
      } else { a[k] = make_uint2(0, 0); b[k] = a[k]; z[k] = a[k]; }
    }
#pragma unroll
    for (int k = 0; k < 4; ++k) {
      const int item = item0 + k * stride;
      if (item >= TTOT * 8) break;
      const int t = item >> 3, hh = item & 7;
      const int col0 = hh * 256 + lane * 4;
      float o0 = bflo(a[k].x) + bflo(b[k].x), o1 = bfhi(a[k].x) + bfhi(b[k].x);
      float o2 = bflo(a[k].y) + bflo(b[k].y), o3 = bfhi(a[k].y) + bfhi(b[k].y);
      if (hh >= 4) {
        float m = wave_sum(o0 + o1 + o2 + o3) * (1.f / 256.f);
        o0 -= m; o1 -= m; o2 -= m; o3 -= m;
      }
      float ss = wave_sum(o0 * o0 + o1 * o1 + o2 * o2 + o3 * o3) * (1.f / 256.f);
      const float rstd = rsqrtf(ss + 1e-6f);
      float4 g = *(const float4*)(p.ab_head_g + li * 2048 + col0);
      float y0 = o0 * rstd * g.x * siluf_(bflo(z[k].x));
      float y1 = o1 * rstd * g.y * siluf_(bfhi(z[k].x));
      float y2 = o2 * rstd * g.z * siluf_(bflo(z[k].y));
      float y3 = o3 * rstd * g.w * siluf_(bfhi(z[k].y));
      uint2 y; y.x = pack2(y0, y1); y.y = pack2(y2, y3);
      *(uint2*)(OF + (size_t)t * 2048 + col0) = y;
    }
  }
}

template <int MODE>
__device__ __forceinline__ void gemm_tile(const Params& p, const u16* __restrict__ A, int lda,
                                          const u16* __restrict__ Bt, int K, int m0, int n0, int layer,
                                          const float* xp, const float* xs, char* smem, float* xdst = nullptr) {
  const int tid = tid_opaque(), lane = tid & 63, w = tid >> 6, l = lane & 15, q = lane >> 4;
  const int wm = w >> 1, wn = w & 1;
  f32x4 acc[4][4];
#pragma unroll
  for (int mi = 0; mi < 4; ++mi)
#pragma unroll
    for (int ni = 0; ni < 4; ++ni) acc[mi][ni] = (f32x4){0.f, 0.f, 0.f, 0.f};
  const int nk = K >> 5;
  const int r0 = tid >> 2, c0 = (tid & 3) ^ ((-(r0 >> 2)) & 3);
  const int r1 = 64 + r0;
  const u16* ga0 = A + (size_t)(m0 + r0) * lda + c0 * 8;
  const u16* ga1 = A + (size_t)(m0 + r1) * lda + c0 * 8;
  const u16* gb0 = Bt + (size_t)(n0 + r0) * K + c0 * 8;
  const u16* gb1 = Bt + (size_t)(n0 + r1) * K + c0 * 8;
  char* ldst = smem + tid * 16;
#define GISSUE(KT)                                                                                         \
  {                                                                                                        \
    char* st_ = ldst + ((KT) & 3) * 16384;                                                                 \
    const int ko_ = (KT) * 32;                                                                             \
    __builtin_amdgcn_global_load_lds((gbl_ptr_t)(ga0 + ko_), (lds_ptr_t)(st_), 16, 0, 0);                  \
    __builtin_amdgcn_global_load_lds((gbl_ptr_t)(ga1 + ko_), (lds_ptr_t)(st_ + 4096), 16, 0, 0);           \
    __builtin_amdgcn_global_load_lds((gbl_ptr_t)(gb0 + ko_), (lds_ptr_t)(st_ + 8192), 16, 0, 0);           \
    __builtin_amdgcn_global_load_lds((gbl_ptr_t)(gb1 + ko_), (lds_ptr_t)(st_ + 12288), 16, 0, 0);          \
  }
  GISSUE(0)
  GISSUE(1)
  GISSUE(2)
  const int aoff = (wm * 64 + l) * 64 + ((q ^ ((-(l >> 2)) & 3)) * 16);
  const int boff = 8192 + (wn * 64 + l) * 64 + ((q ^ ((-(l >> 2)) & 3)) * 16);
  bf16x8 a0[4], b0[4], a1[4], b1[4];
#define GWAIT(KT)                                                            \
  if ((KT) + 2 < nk) asm volatile("s_waitcnt vmcnt(8)" ::: "memory");        \
  else if ((KT) + 1 < nk) asm volatile("s_waitcnt vmcnt(4)" ::: "memory");   \
  else asm volatile("s_waitcnt vmcnt(0)" ::: "memory");                      \
  __builtin_amdgcn_s_barrier();
#define GREAD(KT, AF, BF)                                                    \
  {                                                                          \
    const char* st_ = smem + ((KT) & 3) * 16384;                             \
    _Pragma("unroll") for (int mi = 0; mi < 4; ++mi) AF[mi] = *(const bf16x8*)(st_ + aoff + mi * 1024); \
    _Pragma("unroll") for (int ni = 0; ni < 4; ++ni) BF[ni] = *(const bf16x8*)(st_ + boff + ni * 1024); \
  }
#define GMMA(AF, BF)                                                         \
  _Pragma("unroll") for (int mi = 0; mi < 4; ++mi)                           \
  _Pragma("unroll") for (int ni = 0; ni < 4; ++ni) acc[mi][ni] = MFMA(AF[mi], BF[ni], acc[mi][ni]);
  GWAIT(0)
  GREAD(0, a0, b0)
#pragma unroll 1
  for (int kt = 0; kt < nk; kt += 2) {
    if (kt + 3 < nk) GISSUE(kt + 3)
    GWAIT(kt + 1)
    GREAD(kt + 1, a1, b1)
    GMMA(a0, b0)
    if (kt + 2 < nk) {
      if (kt + 4 < nk) GISSUE(kt + 4)
      GWAIT(kt + 2)
      GREAD(kt + 2, a0, b0)
    }
    GMMA(a1, b1)
  }
  __syncthreads();
  if (MODE == 2) {
    float* tile = (float*)smem;
#pragma unroll
    for (int mi = 0; mi < 4; ++mi)
#pragma unroll
      for (int ni = 0; ni < 4; ++ni)
#pragma unroll
        for (int r = 0; r < 4; ++r)
          tile[(wm * 64 + mi * 16 + q * 4 + r) * 132 + wn * 64 + ni * 16 + l] = acc[mi][ni][r];
    __syncthreads();
#pragma unroll 4
    for (int i = 0; i < 16; ++i) {
      const int id = tid + 256 * i, row = id >> 5, cc = id & 31;
      const int grow = m0 + row, gcol = n0 + cc * 4;
      const float4 v = *(const float4*)(tile + row * 132 + cc * 4);
      const float4 g = *(const float4*)(p.mod + (size_t)(layer * 9 + cidx_of(grow)) * 3072 + 2048 + gcol);
      const float* xr = grow < TCTX ? xp + (size_t)grow * 1024 + gcol : xs + (size_t)(grow - TCTX) * 1024 + gcol;
      const float4 xi = *(const float4*)xr;
      float4 o;
      o.x = xi.x + g.x * v.x; o.y = xi.y + g.y * v.y; o.z = xi.z + g.z * v.z; o.w = xi.w + g.w * v.w;
      *(float4*)(xdst + (size_t)grow * 1024 + gcol) = o;
    }
  } else if (MODE == 1 && n0 < 3072) {
    u16* tile = (u16*)smem;
#pragma unroll
    for (int mi = 0; mi < 4; ++mi)
#pragma unroll
      for (int ni = 0; ni < 4; ++ni) {
        uint2 o; o.x = pack2(acc[mi][ni][0], acc[mi][ni][1]); o.y = pack2(acc[mi][ni][2], acc[mi][ni][3]);
        *(uint2*)(tile + (wn * 64 + ni * 16 + l) * 136 + wm * 64 + mi * 16 + q * 4) = o;
      }
    __syncthreads();
#pragma unroll
    for (int i = 0; i < 8; ++i) {
      const int id = tid + 256 * i, col = id >> 4, cc = id & 15;
      *(uint4*)(p.R1 + (size_t)(n0 + col) * TTOT + m0 + cc * 8) = *(const uint4*)(tile + col * 136 + cc * 8);
    }
  } else {
    u16* tile = (u16*)smem;
#pragma unroll
    for (int mi = 0; mi < 4; ++mi)
#pragma unroll
      for (int ni = 0; ni < 4; ++ni)
#pragma unroll
        for (int r = 0; r < 4; ++r)
          tile[(wm * 64 + mi * 16 + q * 4 + r) * 136 + wn * 64 + ni * 16 + l] = f2bf(acc[mi][ni][r]);
    if (MODE == 0 && n0 == 2048 && wn == 0) {
#pragma unroll
      for (int mi = 0; mi < 4; ++mi)
#pragma unroll
        for (int ni = 0; ni < 2; ++ni)
#pragma unroll
          for (int r = 0; r < 4; ++r)
            p.ga32[(size_t)(m0 + wm * 64 + mi * 16 + q * 4 + r) * 32 + ni * 16 + l] = acc[mi][ni][r];
    }
    __syncthreads();
    u16* dst = MODE == 0 ? p.R1 + (size_t)m0 * NPAB + n0 : p.R1 + (size_t)3072 * TTOT + (size_t)m0 * 3072 + (n0 - 3072);
    const int ldd = MODE == 0 ? NPAB : 3072;
#pragma unroll
    for (int i = 0; i < 8; ++i) {
      const int id = tid + 256 * i, row = id >> 4, cc = id & 15;
      *(uint4*)(dst + (size_t)row * ldd + cc * 8) = *(const uint4*)(tile + row * 136 + cc * 8);
    }
  }
  __syncthreads();
}

template <int MODE>
__device__ __forceinline__ void gemm_big(const Params& p, const u16* __restrict__ A, const u16* __restrict__ Bt,
                                         int m0, int n0, char* smem, const int K = 1024, int layer = 0,
                                         const float* xp = nullptr, const float* xs = nullptr) {
  const int nk = K >> 5;
  const int tid = tid_opaque(), lane = tid & 63, w = tid >> 6, l = lane & 15, q = lane >> 4;
  const int wm = w >> 1, wn = w & 1;
  f32x4 acc[8][4];
#pragma unroll
  for (int mi = 0; mi < 8; ++mi)
#pragma unroll
    for (int ni = 0; ni < 4; ++ni) acc[mi][ni] = (f32x4){0.f, 0.f, 0.f, 0.f};
  const int r0 = tid >> 2, c0 = (tid & 3) ^ ((-(r0 >> 2)) & 3);
  const u16* ga = A + (size_t)(m0 + r0) * K + c0 * 8;
  const u16* gb = Bt + (size_t)(n0 + r0) * K + c0 * 8;
  const size_t r64 = (size_t)64 * K;
  char* ldst = smem + tid * 16;
#define BISSUE(KT, BUF)                                                                                      \
  {                                                                                                          \
    char* st_ = ldst + (BUF) * 24576;                                                                        \
    const int ko_ = (KT) * 32;                                                                               \
    __builtin_amdgcn_global_load_lds((gbl_ptr_t)(ga + ko_), (lds_ptr_t)(st_), 16, 0, 0);                     \
    __builtin_amdgcn_global_load_lds((gbl_ptr_t)(ga + r64 + ko_), (lds_ptr_t)(st_ + 4096), 16, 0, 0);      \
    __builtin_amdgcn_global_load_lds((gbl_ptr_t)(ga + 2 * r64 + ko_), (lds_ptr_t)(st_ + 8192), 16, 0, 0);     \
    __builtin_amdgcn_global_load_lds((gbl_ptr_t)(ga + 3 * r64 + ko_), (lds_ptr_t)(st_ + 12288), 16, 0, 0);    \
    __builtin_amdgcn_global_load_lds((gbl_ptr_t)(gb + ko_), (lds_ptr_t)(st_ + 16384), 16, 0, 0);             \
    __builtin_amdgcn_global_load_lds((gbl_ptr_t)(gb + r64 + ko_), (lds_ptr_t)(st_ + 20480), 16, 0, 0);     \
  }
  BISSUE(0, 0)
  BISSUE(1, 1)
  const int swz = (q ^ ((-(l >> 2)) & 3)) * 16;
  const int aoff = (wm * 128 + l) * 64 + swz;
  const int boff = 16384 + (wn * 64 + l) * 64 + swz;
  int buf = 0;
#pragma unroll 1
  for (int kt = 0; kt < nk; ++kt) {
    if (kt + 1 < nk) asm volatile("s_waitcnt vmcnt(6)" ::: "memory");
    else asm volatile("s_waitcnt vmcnt(0)" ::: "memory");
    __builtin_amdgcn_s_barrier();
    if (kt + 2 < nk) {
      const int nb = buf == 0 ? 2 : buf - 1;
      BISSUE(kt + 2, nb)
    }
    const char* st = smem + buf * 24576;
    bf16x8 b[4];
#pragma unroll
    for (int ni = 0; ni < 4; ++ni) b[ni] = *(const bf16x8*)(st + boff + ni * 1024);
#pragma unroll
    for (int mi = 0; mi < 8; ++mi) {
      const bf16x8 a = *(const bf16x8*)(st + aoff + mi * 1024);
#pragma unroll
      for (int ni = 0; ni < 4; ++ni) acc[mi][ni] = MFMA(a, b[ni], acc[mi][ni]);
    }
    buf = buf == 2 ? 0 : buf + 1;
  }
  __syncthreads();
  if (MODE == 2) {
    float* tile = (float*)smem;
#pragma unroll 1
    for (int h = 0; h < 2; ++h) {
      if (wm == h) {
#pragma unroll
        for (int mi = 0; mi < 8; ++mi)
#pragma unroll
          for (int ni = 0; ni < 4; ++ni)
#pragma unroll
            for (int r = 0; r < 4; ++r) tile[(mi * 16 + q * 4 + r) * 132 + wn * 64 + ni * 16 + l] = acc[mi][ni][r];
      }
      __syncthreads();
#pragma unroll 4
      for (int i = 0; i < 16; ++i) {
        const int id = tid + 256 * i, row = id >> 5, cc = id & 31;
        const int grow = m0 + h * 128 + row, gcol = n0 + cc * 4;
        const float4 v = *(const float4*)(tile + row * 132 + cc * 4);
        const float4 gg = *(const float4*)(p.mod + (size_t)(layer * 9 + cidx_of(grow)) * 3072 + 2048 + gcol);
        const float* xr = grow < TCTX ? xp + (size_t)grow * 1024 + gcol : xs + (size_t)(grow - TCTX) * 1024 + gcol;
        const float4 xi = *(const float4*)xr;
        float4 o;
        o.x = xi.x + gg.x * v.x; o.y = xi.y + gg.y * v.y; o.z = xi.z + gg.z * v.z; o.w = xi.w + gg.w * v.w;
        *(float4*)(p.out + (size_t)grow * 1024 + gcol) = o;
      }
      __syncthreads();
    }
    return;
  }
  if (MODE == 1 && n0 < 3072) {
    u16* tile = (u16*)smem;
#pragma unroll
    for (int mi = 0; mi < 8; ++mi)
#pragma unroll
      for (int ni = 0; ni < 4; ++ni) {
        uint2 o; o.x = pack2(acc[mi][ni][0], acc[mi][ni][1]); o.y = pack2(acc[mi][ni][2], acc[mi][ni][3]);
        *(uint2*)(tile + (wn * 64 + ni * 16 + l) * 264 + wm * 128 + mi * 16 + q * 4) = o;
      }
    __syncthreads();
#pragma unroll 4
    for (int i = 0; i < 16; ++i) {
      const int id = tid + 256 * i, col = id >> 5, cc = id & 31;
      *(uint4*)(p.R1 + (size_t)(n0 + col) * TTOT + m0 + cc * 8) = *(const uint4*)(tile + col * 264 + cc * 8);
    }
  } else {
    u16* tile = (u16*)smem;
#pragma unroll
    for (int mi = 0; mi < 8; ++mi)
#pragma unroll
      for (int ni = 0; ni < 4; ++ni)
#pragma unroll
        for (int r = 0; r < 4; ++r)
          tile[(wm * 128 + mi * 16 + q * 4 + r) * 136 + wn * 64 + ni * 16 + l] = f2bf(acc[mi][ni][r]);
    if (MODE == 0 && n0 == 2048 && wn == 0) {
#pragma unroll
      for (int mi = 0; mi < 8; ++mi)
#pragma unroll
        for (int ni = 0; ni < 2; ++ni)
#pragma unroll
          for (int r = 0; r < 4; ++r)
            p.ga32[(size_t)(m0 + wm * 128 + mi * 16 + q * 4 + r) * 32 + ni * 16 + l] = acc[mi][ni][r];
    }
    __syncthreads();
    u16* dst = MODE == 0 ? p.R1 + (size_t)m0 * NPAB + n0 : p.R1 + (size_t)3072 * TTOT + (size_t)m0 * 3072 + (n0 - 3072);
    const int ldd = MODE == 0 ? NPAB : 3072;
#pragma unroll 4
    for (int i = 0; i < 16; ++i) {
      const int id = tid + 256 * i, row = id >> 4, cc = id & 15;
      *(uint4*)(dst + (size_t)row * ldd + cc * 8) = *(const uint4*)(tile + row * 136 + cc * 8);
    }
  }
  __syncthreads();
}

__device__ __forceinline__ void gemm_thin(const Params& p, const u16* __restrict__ A, const u16* __restrict__ Bt,
                                          int m0, char* smem) {
  const int n0 = 6144;
  const int tid = tid_opaque(), lane = tid & 63, w = tid >> 6, l = lane & 15, q = lane >> 4;
  f32x4 acc[4][2];
#pragma unroll
  for (int mi = 0; mi < 4; ++mi)
#pragma unroll
    for (int ni = 0; ni < 2; ++ni) acc[mi][ni] = (f32x4){0.f, 0.f, 0.f, 0.f};
  const int r0 = tid >> 2, c0 = (tid & 3) ^ ((-(r0 >> 2)) & 3);
  const u16* ga = A + (size_t)(m0 + r0) * 1024 + c0 * 8;
  const u16* gb = Bt + (size_t)(n0 + (r0 & 31)) * 1024 + c0 * 8;
  char* ldst = smem + tid * 16;
  const bool bl = w < 2;
#define TISSUE(KT, BUF)                                                                                      \
  {                                                                                                          \
    char* st_ = ldst + (BUF) * 24576;                                                                        \
    const int ko_ = (KT) * 32;                                                                               \
    __builtin_amdgcn_global_load_lds((gbl_ptr_t)(ga + ko_), (lds_ptr_t)(st_), 16, 0, 0);                     \
    __builtin_amdgcn_global_load_lds((gbl_ptr_t)(ga + 65536 + ko_), (lds_ptr_t)(st_ + 4096), 16, 0, 0);      \
    __builtin_amdgcn_global_load_lds((gbl_ptr_t)(ga + 131072 + ko_), (lds_ptr_t)(st_ + 8192), 16, 0, 0);     \
    __builtin_amdgcn_global_load_lds((gbl_ptr_t)(ga + 196608 + ko_), (lds_ptr_t)(st_ + 12288), 16, 0, 0);    \
    if (bl) __builtin_amdgcn_global_load_lds((gbl_ptr_t)(gb + ko_), (lds_ptr_t)(st_ + 16384), 16, 0, 0);     \
  }
  TISSUE(0, 0)
  TISSUE(1, 1)
  const int swz = (q ^ ((-(l >> 2)) & 3)) * 16;
  const int aoff = (w * 64 + l) * 64 + swz;
  const int boff = 16384 + l * 64 + swz;
  int buf = 0;
#pragma unroll 1
  for (int kt = 0; kt < 32; ++kt) {
    if (kt + 1 < 32) {
      if (bl) asm volatile("s_waitcnt vmcnt(5)" ::: "memory");
      else asm volatile("s_waitcnt vmcnt(4)" ::: "memory");
    } else asm volatile("s_waitcnt vmcnt(0)" ::: "memory");
    __builtin_amdgcn_s_barrier();
    if (kt + 2 < 32) {
      const int nb = buf == 0 ? 2 : buf - 1;
      TISSUE(kt + 2, nb)
    }
    const char* st = smem + buf * 24576;
    bf16x8 b[2];
#pragma unroll
    for (int ni = 0; ni < 2; ++ni) b[ni] = *(const bf16x8*)(st + boff + ni * 1024);
#pragma unroll
    for (int mi = 0; mi < 4; ++mi) {
      const bf16x8 a = *(const bf16x8*)(st + aoff + mi * 1024);
#pragma unroll
      for (int ni = 0; ni < 2; ++ni) acc[mi][ni] = MFMA(a, b[ni], acc[mi][ni]);
    }
    buf = buf == 2 ? 0 : buf + 1;
  }
  __syncthreads();
  u16* tile = (u16*)smem;
#pragma unroll
  for (int mi = 0; mi < 4; ++mi)
#pragma unroll
    for (int ni = 0; ni < 2; ++ni)
#pragma unroll
      for (int r = 0; r < 4; ++r) tile[(w * 64 + mi * 16 + q * 4 + r) * 40 + ni * 16 + l] = f2bf(acc[mi][ni][r]);
  __syncthreads();
#pragma unroll
  for (int i = 0; i < 4; ++i) {
    const int id = tid + 256 * i, row = id >> 2, cc = id & 3;
    *(uint4*)(p.R1 + (size_t)(m0 + row) * NPAB + n0 + cc * 8) = *(const uint4*)(tile + row * 40 + cc * 8);
  }
  __syncthreads();
}

__device__ __forceinline__ void gla_step23(f32x4 (&S)[8], const int vrow0, const u16* VT, const u16* ATT, const u16* Qs,
                                           const u16* KT, const float* DEC, u16* O, const int w, const int l,
                                           const int q, const int tokbase, const int dir, const int cpos,
                                           const int ocol) {
    {
      f32x4 oacc[4];
#pragma unroll
      for (int ni = 0; ni < 4; ++ni) oacc[ni] = (f32x4){0.f, 0.f, 0.f, 0.f};
      bf16x8 vfr[2];
#pragma unroll
      for (int ks = 0; ks < 2; ++ks) {
        vfr[ks] = *(const bf16x8*)(VT + (vrow0 + l) * 72 + ((32 * ks + 8 * q) ^ (8 * (((vrow0 + l) >> 3) & 7))));
#pragma unroll
        for (int ni = 0; ni < 4; ++ni) {
          bf16x8 bfr = *(const bf16x8*)(ATT + (16 * ni + l) * 72 + 32 * ks + 8 * q);
          oacc[ni] = MFMA(vfr[ks], bfr, oacc[ni]);
        }
      }
      __builtin_amdgcn_sched_barrier(0);
#pragma unroll
      for (int pp = 0; pp < 4; ++pp) {
        V8 sa;
        sa.w[0] = pack2(S[2 * pp][0], S[2 * pp][1]);
        sa.w[1] = pack2(S[2 * pp][2], S[2 * pp][3]);
        sa.w[2] = pack2(S[2 * pp + 1][0], S[2 * pp + 1][1]);
        sa.w[3] = pack2(S[2 * pp + 1][2], S[2 * pp + 1][3]);
#pragma unroll
        for (int ni = 0; ni < 4; ++ni) {
          V8 bq;
          bq.u2[0] = *(const uint2*)(Qs + (16 * ni + l) * 136 + 32 * pp + 4 * q);
          bq.u2[1] = *(const uint2*)(Qs + (16 * ni + l) * 136 + 32 * pp + 16 + 4 * q);
          oacc[ni] = MFMA(sa.v, bq.v, oacc[ni]);
        }
      }
      __builtin_amdgcn_sched_barrier(0);
#pragma unroll
      for (int ni = 0; ni < 4; ++ni) {
        const int i = 16 * ni + l;
        const int tok = tokbase + (dir ? cpos + 63 - i : cpos + i);
        uint2 o; o.x = pack2(oacc[ni][0], oacc[ni][1]); o.y = pack2(oacc[ni][2], oacc[ni][3]);
        *(uint2*)(O + (size_t)tok * 2048 + ocol + vrow0 + 4 * q) = o;
      }
      __builtin_amdgcn_sched_barrier(0);
#pragma unroll
      for (int mi = 0; mi < 8; ++mi) {
        if ((mi & 1) == 0) __builtin_amdgcn_sched_barrier(0);
#pragma unroll
        for (int ks = 0; ks < 2; ++ks) {
          bf16x8 a = *(const bf16x8*)(KT + (16 * mi + l) * 72 + 32 * ks + 8 * q);
          S[mi] = MFMA(a, vfr[ks], S[mi]);
        }
        const float4 dc = *(const float4*)(DEC + 16 * mi + 4 * q);
        S[mi][0] *= dc.x; S[mi][1] *= dc.y; S[mi][2] *= dc.z; S[mi][3] *= dc.w;
      }
    }
}

__device__ void gla_unit(const Params& p, int li, int unit, char* smem) {
  u16* Qs = (u16*)smem;
  u16* Ks = Qs + 64 * 136;
  u16* KT = Ks + 64 * 136;
  u16* VT = KT + 128 * 72;
  u16* GAh = VT + 64 * 72;
  float* DEC = (float*)(GAh + 64 * 40);
  u16* ATT = (u16*)(DEC + 128);
  const int tid = tid_opaque(), lane = tid & 63, w = tid >> 6, l = lane & 15, q = lane >> 4;
  int b, tokbase, nch, u = unit;
  bool latent;
  if (unit < 512) { latent = true; b = u >> 6; tokbase = TCTX + b * 2048; nch = 32; }
  else { latent = false; u = unit - 512; b = u >> 6; tokbase = b * 256; nch = 4; }
  const int sl = u & 3, dir = (u >> 2) & 1, hd = (u >> 3) & 3, ty = (u >> 5) & 1;
  const int qcol = ty == 0 ? hd * 128 : 3104 + hd * 128;
  const int kcol = ty == 0 ? 512 + hd * 128 : 3616 + hd * 128;
  const int vcol = (ty == 0 ? 1024 : 4128) + hd * 256 + sl * 64;
  const int ocol = ty * 1024 + hd * 256 + sl * 64;
  const u16* PROJ = p.R1;
  u16* O = dir ? p.R3 : p.R2;
  V8 w2h[2];
  float gb[2] = {0.f, 0.f};
  float ldec = 0.f;
#pragma unroll
  for (int ni = 0; ni < 2; ++ni) w2h[ni].u4 = make_uint4(0, 0, 0, 0);
  if (ty == 0) {
#pragma unroll
    for (int ni = 0; ni < 2; ++ni) {
      const int d = 32 * w + 16 * ni + l;
      const float* wp = p.ab_gate_w2 + (size_t)((li * 2 + dir) * 16 + 8 * (q & 1)) * 512 + hd * 128 + d;
      float hv[8];
#pragma unroll
      for (int e = 0; e < 8; ++e) hv[e] = wp[e * 512];
#pragma unroll
      for (int e = 0; e < 4; ++e) w2h[ni].w[e] = pack2(hv[2 * e], hv[2 * e + 1]);
      gb[ni] = p.ab_gate_b[(li * 2 + dir) * 512 + hd * 128 + d];
    }
  } else {
    float expo = 5.f + (7.f / 3.f) * ((float)hd + 0.5f * (float)dir);
    ldec = log1pf(-exp2f(-expo));
  }
  const float qs = ty == 0 ? 0.08838834764831845f : 1.f;
  const float ksc = ty == 0 ? 1.f : 0.08838834764831845f;
  f32x4 S0[8];
  const size_t sbase = ((((size_t)b * 2 + li) * 2 + dir) * 4 + hd) * 128 * 256;
  const int svcol = sl * 64 + 16 * w + l;
  if (latent) {
    const float* sin_ = ty == 0 ? p.state_gla : p.state_ret;
#pragma unroll
    for (int mi = 0; mi < 8; ++mi)
#pragma unroll
      for (int r = 0; r < 4; ++r) S0[mi][r] = sin_[sbase + (size_t)(16 * mi + 4 * q + r) * 256 + svcol];
  } else {
#pragma unroll
    for (int mi = 0; mi < 8; ++mi) S0[mi] = (f32x4){0.f, 0.f, 0.f, 0.f};
  }
  uint4 rq0, rq1, rq2, rq3, rk0, rk1, rk2, rk3, rv0, rv1;
  float4 rga;
  const int qrow = tid >> 4, qcc = tid & 15;
  const int vrow = tid >> 3, vcc = tid & 7;
  const int grow = tid >> 2, gcc = tid & 3;
#define GLA_TOK(CP, ROW) (tokbase + (dir ? (CP) + 63 - (ROW) : (CP) + (ROW)))
#define GLA_PREFETCH(CP)                                                                              \
  {                                                                                                   \
    const u16* b0_ = PROJ + (size_t)GLA_TOK(CP, qrow) * NPAB + qcc * 8;                               \
    const u16* b1_ = PROJ + (size_t)GLA_TOK(CP, qrow + 16) * NPAB + qcc * 8;                          \
    const u16* b2_ = PROJ + (size_t)GLA_TOK(CP, qrow + 32) * NPAB + qcc * 8;                          \
    const u16* b3_ = PROJ + (size_t)GLA_TOK(CP, qrow + 48) * NPAB + qcc * 8;                          \
    rq0 = *(const uint4*)(b0_ + qcol); rk0 = *(const uint4*)(b0_ + kcol);                             \
    rq1 = *(const uint4*)(b1_ + qcol); rk1 = *(const uint4*)(b1_ + kcol);                             \
    rq2 = *(const uint4*)(b2_ + qcol); rk2 = *(const uint4*)(b2_ + kcol);                             \
    rq3 = *(const uint4*)(b3_ + qcol); rk3 = *(const uint4*)(b3_ + kcol);                             \
  }
#define GLA_PREFETCH_V(CP)                                                                            \
  {                                                                                                   \
    rv0 = *(const uint4*)(PROJ + (size_t)GLA_TOK(CP, vrow) * NPAB + vcc * 8 + vcol);                  \
    rv1 = *(const uint4*)(PROJ + (size_t)GLA_TOK(CP, vrow + 32) * NPAB + vcc * 8 + vcol);             \
    rga = *(const float4*)(p.ga32 + (size_t)GLA_TOK(CP, grow) * 32 + dir * 16 + gcc * 4);             \
  }
  {
    const int cpos0 = 64 * (dir ? nch - 1 : 0);
    GLA_PREFETCH(cpos0)
    GLA_PREFETCH_V(cpos0)
  }
#pragma unroll 1
  for (int n = 0; n < nch; ++n) {
    const int cpos = 64 * (dir ? nch - 1 - n : n);
    __syncthreads();
    {
      u16* dq = Qs + qrow * 136 + qcc * 8;
      u16* dk = Ks + qrow * 136 + qcc * 8;
      *(uint4*)(dq) = rq0; *(uint4*)(dq + 16 * 136) = rq1; *(uint4*)(dq + 32 * 136) = rq2; *(uint4*)(dq + 48 * 136) = rq3;
      *(uint4*)(dk) = rk0; *(uint4*)(dk + 16 * 136) = rk1; *(uint4*)(dk + 32 * 136) = rk2; *(uint4*)(dk + 48 * 136) = rk3;
      V8 t0, t1; t0.u4 = rv0; t1.u4 = rv1;
#pragma unroll
      for (int e = 0; e < 8; ++e) {
        u16* vp = VT + (vcc * 8 + e) * 72;
        vp[vrow ^ (8 * vcc)] = t0.h[e]; vp[(vrow + 32) ^ (8 * vcc)] = t1.h[e];
      }
      if (ty == 0) {
        const float h0 = bf2f(f2bf(rga.x)), h1 = bf2f(f2bf(rga.y)), h2 = bf2f(f2bf(rga.z)), h3 = bf2f(f2bf(rga.w));
        uint2 hi, lo;
        hi.x = pack2(h0, h1); hi.y = pack2(h2, h3);
        lo.x = pack2(rga.x - h0, rga.y - h1); lo.y = pack2(rga.z - h2, rga.w - h3);
        *(uint2*)(GAh + grow * 40 + gcc * 4) = hi;
        *(uint2*)(GAh + grow * 40 + 16 + gcc * 4) = lo;
      }
    }
    __syncthreads();
    if (n + 1 < nch) {
      const int cpos2 = 64 * (dir ? nch - 2 - n : n + 1);
      GLA_PREFETCH(cpos2)
    }
    {
      float carry[2] = {0.f, 0.f};
#pragma unroll
      for (int mi = 0; mi < 4; ++mi) {
        bf16x8 a;
        float eqs[4] = {0.f, 0.f, 0.f, 0.f}, eks[4] = {0.f, 0.f, 0.f, 0.f};
        if (ty == 0) a = *(const bf16x8*)(GAh + (16 * mi + l) * 40 + 8 * q);
#pragma unroll
        for (int ni = 0; ni < 2; ++ni) {
          float c[4];
          if (ty == 0) {
            f32x4 lg = (f32x4){0.f, 0.f, 0.f, 0.f};
            lg = MFMA(a, w2h[ni].v, lg);
            float run = 0.f;
#pragma unroll
            for (int r = 0; r < 4; ++r) {
              const float s = lg[r] + gb[ni];
              run += (fminf(s, 0.f) - __logf(1.f + __expf(-fabsf(s)))) * (1.f / 16.f);
              c[r] = run;
            }
            const float T = run;
            const float u1 = __shfl_up(T, 16);
            const float T1 = q >= 1 ? T + u1 : T;
            const float u2 = __shfl_up(T1, 32);
            const float T2 = q >= 2 ? T1 + u2 : T1;
            const float tot = __shfl(T2, 48 + l);
            const float base = carry[ni] + (T2 - T);
#pragma unroll
            for (int r = 0; r < 4; ++r) c[r] += base;
            carry[ni] += tot;
          } else {
#pragma unroll
            for (int r = 0; r < 4; ++r) c[r] = (float)(16 * mi + 4 * q + r + 1) * ldec;
          }
          const int j0 = 16 * mi + 4 * q, d = 32 * w + 16 * ni + l;
          float ks4[4];
          float eq[4], ek[4];
          if (ty == 0 || ni == 0) {
#pragma unroll
            for (int r = 0; r < 4; ++r) { eq[r] = qs * __expf(c[r]); ek[r] = ksc * __expf(-c[r]); }
          }
          if (ty != 0 && ni == 0) {
#pragma unroll
            for (int r = 0; r < 4; ++r) { eqs[r] = eq[r]; eks[r] = ek[r]; }
          }
          if (ty != 0 && ni != 0) {
#pragma unroll
            for (int r = 0; r < 4; ++r) { eq[r] = eqs[r]; ek[r] = eks[r]; }
          }
#pragma unroll
          for (int r = 0; r < 4; ++r) {
            u16* qp = Qs + (j0 + r) * 136 + d;
            u16* kp = Ks + (j0 + r) * 136 + d;
            const float qv = bf2f(*qp), kv = bf2f(*kp);
            *qp = f2bf(qv * eq[r]);
            ks4[r] = kv * ek[r];
            *kp = f2bf(ks4[r]);
          }
          uint2 o; o.x = pack2(ks4[0], ks4[1]); o.y = pack2(ks4[2], ks4[3]);
          *(uint2*)(KT + d * 72 + j0) = o;
        }
      }
      if (q == 0) {
        DEC[32 * w + l] = __expf(ty == 0 ? carry[0] : 64.f * ldec);
        DEC[32 * w + 16 + l] = __expf(ty == 0 ? carry[1] : 64.f * ldec);
      }
    }
    __syncthreads();
    __builtin_amdgcn_sched_barrier(0);
    f32x4 at[4];
#pragma unroll
    for (int ni = 0; ni < 4; ++ni) at[ni] = (f32x4){0.f, 0.f, 0.f, 0.f};
#pragma unroll
    for (int ks = 0; ks < 4; ++ks) {
      bf16x8 a = *(const bf16x8*)(Qs + (16 * w + l) * 136 + 32 * ks + 8 * q);
#pragma unroll
      for (int ni = 0; ni < 4; ++ni) {
        bf16x8 bfr = *(const bf16x8*)(Ks + (16 * ni + l) * 136 + 32 * ks + 8 * q);
        at[ni] = MFMA(a, bfr, at[ni]);
      }
    }
#pragma unroll
    for (int ni = 0; ni < 4; ++ni)
#pragma unroll
      for (int r = 0; r < 4; ++r) {
        const int i = 16 * w + 4 * q + r, j = 16 * ni + l;
        ATT[i * 72 + j] = f2bf(j <= i ? at[ni][r] : 0.f);
      }
    __syncthreads();
    __builtin_amdgcn_sched_barrier(0);
    gla_step23(S0, 16 * w, VT, ATT, Qs, KT, DEC, O, w, l, q, tokbase, dir, cpos, ocol);
    __builtin_amdgcn_sched_barrier(0);
    if (n + 1 < nch) {
      const int cpos3 = 64 * (dir ? nch - 2 - n : n + 1);
      GLA_PREFETCH_V(cpos3)
    }
  }
  if (!latent) {
    float* so = p.out + (ty == 0 ? OFF_GLA : OFF_RET);
#pragma unroll
    for (int mi = 0; mi < 8; ++mi)
#pragma unroll
      for (int r = 0; r < 4; ++r) so[sbase + (size_t)(16 * mi + 4 * q + r) * 256 + svcol] = S0[mi][r];
  }
}

template <int GRP>
__device__ void conv_unit(const Params& p, int li, int c, char* smem) {
  constexpr int L = GRP ? 2048 : 256;
  constexpr int NB = GRP ? 8 : 32;
  constexpr int NI = GRP ? 4 : 2;
  constexpr int NIB = L / 64;
  constexpr int TOK0 = GRP ? TCTX : 0;
  constexpr int HCS = 2 * L + 8;
  constexpr int UBS = L + 8;
  constexpr int CPT = NB * L / 8 / 256;
  u16* HC = (u16*)smem;
  u16* UB = HC + 4 * HCS;
  u16* XR = GRP ? HC : UB + NB * UBS;
  const int tid = tid_opaque(), lane = tid & 63, w = tid >> 6, l = lane & 15, q = lane >> 4;
  const u16* UT = p.R1;
  u16* Z2T = p.H;
  const float* sw = p.hy_short_w + li * 3 * 3072;
  const float* sb = p.hy_short_b + li * 3072;
  __syncthreads();
  {
    const u16* src = UT + (size_t)c * TTOT + TOK0;
    uint4 raw[CPT];
#pragma unroll
    for (int k = 0; k < CPT; ++k) raw[k] = *(const uint4*)(src + (size_t)(tid + 256 * k) * 8);
#pragma unroll
    for (int k = 0; k < CPT; ++k) {
      const int ch = tid + 256 * k, bq = ch / (L / 8), p0 = (ch % (L / 8)) * 8;
      *(uint4*)(UB + bq * UBS + p0) = raw[k];
    }
    __syncthreads();
    const float w0 = sw[c], w1 = sw[3072 + c], w2 = sw[6144 + c], bs = sb[c];
#pragma unroll
    for (int k = 0; k < CPT; ++k) {
      const int ch = tid + 256 * k, bq = ch / (L / 8), p0 = (ch % (L / 8)) * 8;
      const u16* s = UB + bq * UBS + p0;
      V8 rw; rw.u4 = raw[k];
      float x[10];
      x[0] = p0 > 0 ? bf2f(s[-1]) : 0.f;
#pragma unroll
      for (int e = 0; e < 8; ++e) x[e + 1] = bf2f(rw.h[e]);
      x[9] = p0 + 8 < L ? bf2f(s[8]) : 0.f;
      V8 o;
#pragma unroll
      for (int e = 0; e < 4; ++e)
        o.w[e] = pack2(w0 * x[2 * e] + w1 * x[2 * e + 1] + w2 * x[2 * e + 2] + bs,
                       w0 * x[2 * e + 1] + w1 * x[2 * e + 2] + w2 * x[2 * e + 3] + bs);
      raw[k] = o.u4;
    }
    __syncthreads();
#pragma unroll
    for (int k = 0; k < CPT; ++k) {
      const int ch = tid + 256 * k, bq = ch / (L / 8), p0 = (ch % (L / 8)) * 8;
      *(uint4*)(UB + bq * UBS + p0) = raw[k];
    }
  }
  const int ncol0 = w * 16 * NI;
  const int Imin = ncol0 / NB, Imax = (ncol0 + 16 * NI - 1) / NB;
  const int cp = (-l) & 3;
#pragma unroll 1
  for (int o = 0; o < 2; ++o) {
    const u16* hr = p.hrev + hrev_off(li, GRP, o, c);
    for (int g = tid; g < 2 * L / 8; g += 256) {
      uint4 A = *(const uint4*)(hr + 8 * g);
      uint4 B = make_uint4(0, 0, 0, 0);
      if (g + 1 < 2 * L / 8) B = *(const uint4*)(hr + 8 * g + 8);
      unsigned wd[8] = {A.x, A.y, A.z, A.w, B.x, B.y, B.z, B.w};
#pragma unroll
      for (int cq = 0; cq < 4; ++cq) {
        uint4 ov;
        unsigned t[4];
#pragma unroll
        for (int k = 0; k < 4; ++k)
          t[k] = (cq & 1) ? ((wd[k + cq / 2] >> 16) | (wd[k + cq / 2 + 1] << 16)) : wd[k + cq / 2];
        ov.x = t[0]; ov.y = t[1]; ov.z = t[2]; ov.w = t[3];
        *(uint4*)(HC + cq * HCS + 8 * g) = ov;
      }
    }
    __syncthreads();
    const int gch = (o + 1) * 1024 + c;
    uint4 xr0, xr1, xr2, xr3, xr4 = make_uint4(0, 0, 0, 0), xr5 = xr4, xr6 = xr4, xr7 = xr4;
    {
      const u16* xsrc = UT + (size_t)gch * TTOT + TOK0 + (size_t)tid * 8;
      xr0 = *(const uint4*)(xsrc); xr1 = *(const uint4*)(xsrc + 2048); xr2 = *(const uint4*)(xsrc + 4096); xr3 = *(const uint4*)(xsrc + 6144);
      if (CPT == 8) {
        xr4 = *(const uint4*)(xsrc + 8192); xr5 = *(const uint4*)(xsrc + 10240); xr6 = *(const uint4*)(xsrc + 12288); xr7 = *(const uint4*)(xsrc + 14336);
      }
    }
    f32x4 acc[4][NI];
#pragma unroll
    for (int mi = 0; mi < 4; ++mi)
#pragma unroll
      for (int ni = 0; ni < NI; ++ni) acc[mi][ni] = (f32x4){0.f, 0.f, 0.f, 0.f};
#pragma unroll 1
    for (int dd = Imin - (NIB - 1); dd <= Imax; ++dd) {
      bf16x8 fr[6];
#pragma unroll
      for (int e6 = 0; e6 < 6; ++e6) {
        const int x0 = L - 64 * dd + 16 * (e6 - 3) + 8 * q - l;
        const u16* a = HC + cp * HCS + (x0 - cp);
        V8 t;
        t.u2[0] = *(const uint2*)a;
        t.u2[1] = *(const uint2*)(a + 4);
        fr[e6] = t.v;
      }
#pragma unroll
      for (int ks = 0; ks < 2; ++ks) {
#pragma unroll
        for (int ni = 0; ni < NI; ++ni) {
          const int Ilo = (ncol0 + 16 * ni) / NB, Ihi = (ncol0 + 16 * ni + 15) / NB;
          if (Ihi - dd < 0 || Ilo - dd >= NIB) continue;
          const int n = ncol0 + 16 * ni + l;
          const int I = n / NB, bb = n % NB;
          const int J = I - dd;
          V8 bfr; bfr.u4 = make_uint4(0, 0, 0, 0);
          if (J >= 0 && J < NIB) bfr.u4 = *(const uint4*)(UB + bb * UBS + 64 * J + 32 * ks + 8 * q);
#pragma unroll
          for (int mi = 0; mi < 4; ++mi) acc[mi][ni] = MFMA(fr[2 * ks - mi + 3], bfr.v, acc[mi][ni]);
        }
      }
    }
    __syncthreads();
    {
      u16* xd = XR + (size_t)tid * 8;
      *(uint4*)(xd) = xr0; *(uint4*)(xd + 2048) = xr1; *(uint4*)(xd + 4096) = xr2; *(uint4*)(xd + 6144) = xr3;
      if (CPT == 8) {
        *(uint4*)(xd + 8192) = xr4; *(uint4*)(xd + 10240) = xr5; *(uint4*)(xd + 12288) = xr6; *(uint4*)(xd + 14336) = xr7;
      }
    }
    __syncthreads();
    const float w0 = sw[gch], w1 = sw[3072 + gch], w2 = sw[6144 + gch], bs = sb[gch];
#pragma unroll
    for (int mi = 0; mi < 4; ++mi) {
#pragma unroll
      for (int ni = 0; ni < NI; ++ni) {
        const int n = ncol0 + 16 * ni + l;
        const int I = n / NB, bb = n % NB;
        const int pp = 64 * I + 16 * mi + 4 * q;
        const u16* s = XR + bb * L + pp;
        const uint2 raw = *(const uint2*)s;
        float x[6];
        x[0] = pp > 0 ? bf2f(s[-1]) : 0.f;
        x[1] = bflo(raw.x); x[2] = bfhi(raw.x); x[3] = bflo(raw.y); x[4] = bfhi(raw.y);
        x[5] = pp + 4 < L ? bf2f(s[4]) : 0.f;
        float z[4];
#pragma unroll
        for (int r = 0; r < 4; ++r) z[r] = (w0 * x[r] + w1 * x[r + 1] + w2 * x[r + 2] + bs) * acc[mi][ni][r];
        uint2 ov; ov.x = pack2(z[0], z[1]); ov.y = pack2(z[2], z[3]);
        *(uint2*)(UB + bb * UBS + pp) = ov;
      }
    }
    __syncthreads();
  }
  {
    u16* dst = Z2T + (size_t)c * TTOT + TOK0;
#pragma unroll
    for (int k = 0; k < CPT; ++k) {
      const int ch = tid + 256 * k, bq = ch / (L / 8), p0 = (ch % (L / 8)) * 8;
      *(uint4*)(dst + (size_t)ch * 8) = *(const uint4*)(UB + bq * UBS + p0);
    }
  }
}

__device__ void lrua_unit(const Params& p, int li, int u, char* smem) {
  u16* XC = (u16*)smem;
  const int tid = tid_opaque(), lane = tid & 63, w = tid >> 6, l = lane & 15, q = lane >> 4;
  const int tt = u >> 3, blk = u & 7, t0 = tt * 64;
  int L, sbase;
  if (t0 < TCTX) { L = 256; sbase = (t0 >> 8) << 8; }
  else { L = 2048; sbase = TCTX + (((t0 - TCTX) >> 11) << 11); }
  const int p0 = t0 - sbase;
  const u16* PR = p.R1 + (size_t)3072 * TTOT;
  u16* LA = p.R2; u16* BB = p.R3;
  __syncthreads();
  {
    const int cc = tid & 15, ch = blk * 128 + cc * 8;
    float wk[4][8], bias[8];
    {
      const float4 b0 = *(const float4*)(p.lru_conv_b + li * 1024 + ch), b1 = *(const float4*)(p.lru_conv_b + li * 1024 + ch + 4);
      bias[0] = b0.x; bias[1] = b0.y; bias[2] = b0.z; bias[3] = b0.w; bias[4] = b1.x; bias[5] = b1.y; bias[6] = b1.z; bias[7] = b1.w;
#pragma unroll
      for (int k = 0; k < 4; ++k) {
        const float* wp = p.lru_conv_w + (li * 4 + k) * 1024 + ch;
        const float4 w0 = *(const float4*)wp, w1 = *(const float4*)(wp + 4);
        wk[k][0] = w0.x; wk[k][1] = w0.y; wk[k][2] = w0.z; wk[k][3] = w0.w;
        wk[k][4] = w1.x; wk[k][5] = w1.y; wk[k][6] = w1.z; wk[k][7] = w1.w;
      }
    }
#pragma unroll 2
    for (int it = 0; it < 4; ++it) {
      const int row = (tid >> 4) + 16 * it;
      uint4 xr[4];
#pragma unroll
      for (int k = 0; k < 4; ++k) {
        const int pp = p0 + row + k - 2;
        xr[k] = (pp >= 0 && pp < L) ? *(const uint4*)(PR + (size_t)(sbase + pp) * 3072 + 1024 + ch) : make_uint4(0, 0, 0, 0);
      }
      float a8[8];
#pragma unroll
      for (int e = 0; e < 8; ++e) a8[e] = bias[e];
#pragma unroll
      for (int k = 0; k < 4; ++k) {
        V8 raw; raw.u4 = xr[k];
#pragma unroll
        for (int e = 0; e < 8; ++e) a8[e] += wk[k][e] * bf2f(raw.h[e]);
      }
      uint4 ov; ov.x = pack2(a8[0], a8[1]); ov.y = pack2(a8[2], a8[3]); ov.z = pack2(a8[4], a8[5]); ov.w = pack2(a8[6], a8[7]);
      *(uint4*)(XC + row * 136 + cc * 8) = ov;
    }
  }
  __syncthreads();
  u16* LAt = XC + 64 * 136;
  u16* BBt = LAt + 64 * 136;
#pragma unroll
  for (int dir = 0; dir < 2; ++dir) {
#pragma unroll
    for (int ni = 0; ni < 2; ++ni) {
      f32x4 ar[4], ai[4];
#pragma unroll
      for (int mi = 0; mi < 4; ++mi) { ar[mi] = (f32x4){0.f, 0.f, 0.f, 0.f}; ai[mi] = (f32x4){0.f, 0.f, 0.f, 0.f}; }
      const u16* wr = p.wlru + (size_t)((((li * 2 + dir) * 8 + blk) * 2) + 0) * 16384;
      const u16* wi = wr + 16384;
      const int nrow = 32 * w + 16 * ni + l;
#pragma unroll
      for (int ks = 0; ks < 4; ++ks) {
        bf16x8 br = *(const bf16x8*)(wr + nrow * 128 + 32 * ks + 8 * q);
        bf16x8 bi = *(const bf16x8*)(wi + nrow * 128 + 32 * ks + 8 * q);
#pragma unroll
        for (int mi = 0; mi < 4; ++mi) {
          bf16x8 a = *(const bf16x8*)(XC + (16 * mi + l) * 136 + 32 * ks + 8 * q);
          ar[mi] = MFMA(a, br, ar[mi]);
          ai[mi] = MFMA(a, bi, ai[mi]);
        }
      }
      const int chl = nrow, C = blk * 128 + chl;
      const float brv = p.lru_b_r[(li * 2 + dir) * 1024 + C], biv = p.lru_b_i[(li * 2 + dir) * 1024 + C];
      const float lam = p.lru_lambda[(li * 2 + dir) * 1024 + C];
      const float sp = log1pf(expf(-lam));
#pragma unroll
      for (int mi = 0; mi < 4; ++mi)
#pragma unroll
        for (int r = 0; r < 4; ++r) {
          const int row = 16 * mi + 4 * q + r;
          const float rr = sigmoidf_(ar[mi][r] + brv), ig = sigmoidf_(ai[mi][r] + biv);
          const float la = -8.f * rr * sp;
          const float e2 = __expf(2.f * la);
          const float om = la > -0.05f ? -2.f * la * (1.f + la * (1.f + la * (2.f / 3.f))) : 1.f - e2;
          const float bbv = __builtin_amdgcn_sqrtf(om) * ig * bf2f(XC[row * 136 + chl]);
          LAt[row * 136 + chl] = f2bf(la);
          BBt[row * 136 + chl] = f2bf(bbv);
        }
    }
    __syncthreads();
    {
      const int ch = tid & 127, hf = tid >> 7;
      float P = 1.f, Hh = 0.f;
#pragma unroll 8
      for (int s = 0; s < 32; ++s) {
        const int row = 32 * hf + (dir ? 31 - s : s);
        const float a = __expf(bf2f(LAt[row * 136 + ch]));
        Hh = a * Hh + bf2f(BBt[row * 136 + ch]);
        P *= a;
      }
      const size_t so = ((size_t)dir * (TTOT / 32) + (t0 >> 5) + hf) * 1024 + blk * 128 + ch;
      p.pseg[so] = P;
      p.hseg[so] = Hh;
    }
#pragma unroll
    for (int i = 0; i < 4; ++i) {
      const int id = tid + 256 * i, row = id >> 4, cc = id & 15;
      const size_t go = ((size_t)dir * TTOT + t0 + row) * 1024 + blk * 128 + cc * 8;
      *(uint4*)(LA + go) = *(const uint4*)(LAt + row * 136 + cc * 8);
      *(uint4*)(BB + go) = *(const uint4*)(BBt + row * 136 + cc * 8);
    }
    __syncthreads();
  }
}

template <int LOGCO>
__device__ void lrub_unit(const Params& p, int li, int u, char* smem) {
  constexpr int NCO = 1 << LOGCO, NSEG = 256 >> LOGCO, CW = 8 * NCO;
  float* PS = (float*)smem;
  float* HS = PS + 2048;
  const int tid = tid_opaque();
  const int co = tid & (NCO - 1), seg = tid >> LOGCO;
  int b, L, base, cg_;
  bool latent;
  if (LOGCO == 2) { latent = true; b = u >> 5; cg_ = u & 31; L = 2048; base = TCTX + b * 2048; }
  else { latent = false; b = u >> 2; cg_ = u & 3; L = 256; base = b * 256; }
  const int C0 = cg_ * CW + co * 8;
  const int SL = L / NSEG;
  const u16* LA = p.R2; const u16* BB = p.R3;
  const u16* PR = p.R1 + (size_t)3072 * TTOT;
  u16* Y = p.R1;
#pragma unroll
  for (int dir = 0; dir < 2; ++dir) {
    const u16* la_ = LA + (size_t)dir * TTOT * 1024 + C0;
    const u16* bb_ = BB + (size_t)dir * TTOT * 1024 + C0;
    __syncthreads();
    {
      const int tseg = dir ? NSEG - 1 - seg : seg;
      const size_t so = ((size_t)dir * (TTOT / 32) + (base >> 5) + tseg) * 1024 + C0;
      *(float4*)(PS + seg * CW + co * 8) = *(const float4*)(p.pseg + so);
      *(float4*)(PS + seg * CW + co * 8 + 4) = *(const float4*)(p.pseg + so + 4);
      *(float4*)(HS + seg * CW + co * 8) = *(const float4*)(p.hseg + so);
      *(float4*)(HS + seg * CW + co * 8 + 4) = *(const float4*)(p.hseg + so + 4);
    }
    __syncthreads();
    float h[8];
    if (latent) {
      const float* sp_ = p.state_lru + ((b * 2 + li) * 2 + dir) * 1024 + C0;
      float4 s0 = *(const float4*)sp_, s1 = *(const float4*)(sp_ + 4);
      h[0] = s0.x; h[1] = s0.y; h[2] = s0.z; h[3] = s0.w; h[4] = s1.x; h[5] = s1.y; h[6] = s1.z; h[7] = s1.w;
    } else {
#pragma unroll
      for (int e = 0; e < 8; ++e) h[e] = 0.f;
    }
    for (int s2 = 0; s2 < seg; ++s2) {
      float4 p0 = *(const float4*)(PS + s2 * CW + co * 8), p1 = *(const float4*)(PS + s2 * CW + co * 8 + 4);
      float4 q0 = *(const float4*)(HS + s2 * CW + co * 8), q1 = *(const float4*)(HS + s2 * CW + co * 8 + 4);
      h[0] = p0.x * h[0] + q0.x; h[1] = p0.y * h[1] + q0.y; h[2] = p0.z * h[2] + q0.z; h[3] = p0.w * h[3] + q0.w;
      h[4] = p1.x * h[4] + q1.x; h[5] = p1.y * h[5] + q1.y; h[6] = p1.z * h[6] + q1.z; h[7] = p1.w * h[7] + q1.w;
    }
#pragma unroll 4
    for (int s = 0; s < SL; ++s) {
      const int pos = dir ? L - 1 - (seg * SL + s) : seg * SL + s;
      const int tkn = base + pos;
      const size_t off = (size_t)tkn * 1024;
      V8 la, bb; la.u4 = *(const uint4*)(la_ + off); bb.u4 = *(const uint4*)(bb_ + off);
#pragma unroll
      for (int e = 0; e < 8; ++e) h[e] = __expf(bf2f(la.h[e])) * h[e] + bf2f(bb.h[e]);
      u16* yp = Y + (size_t)tkn * 2048 + 1024 + C0;
      V8 o;
      if (dir == 0) {
#pragma unroll
        for (int e = 0; e < 4; ++e) o.w[e] = pack2(h[2 * e], h[2 * e + 1]);
      } else {
        V8 hf, zr; hf.u4 = *(const uint4*)yp; zr.u4 = *(const uint4*)(PR + (size_t)tkn * 3072 + 2048 + C0);
#pragma unroll
        for (int e = 0; e < 4; ++e)
          o.w[e] = pack2((bf2f(hf.h[2 * e]) + h[2 * e]) * siluf_(bf2f(zr.h[2 * e])),
                         (bf2f(hf.h[2 * e + 1]) + h[2 * e + 1]) * siluf_(bf2f(zr.h[2 * e + 1])));
      }
      *(uint4*)yp = o.u4;
    }
    if (!latent && seg == NSEG - 1) {
      float* so = p.out + OFF_LRU + ((b * 2 + li) * 2 + dir) * 1024 + C0;
      *(float4*)so = make_float4(h[0], h[1], h[2], h[3]);
      *(float4*)(so + 4) = make_float4(h[4], h[5], h[6], h[7]);
    }
  }
}

__device__ void c2_trans_unit(const Params& p, int u, char* smem) {
  u16* tile = (u16*)smem;
  const int tid = tid_opaque();
  const int tt = u >> 4, ct = u & 15, t0 = tt * 64, c0 = ct * 64;
  const u16* Z2T = p.H;
  const u16* PR = p.R1 + (size_t)3072 * TTOT;
  u16* Y = p.R1;
  __syncthreads();
  {
    const int r = tid >> 2, part = tid & 3;
    const u16* s = Z2T + (size_t)(c0 + r) * TTOT + t0 + part * 16;
    *(uint4*)(tile + r * 72 + part * 16) = *(const uint4*)s;
    *(uint4*)(tile + r * 72 + part * 16 + 8) = *(const uint4*)(s + 8);
  }
  __syncthreads();
  {
    const int t = tid >> 2, cpart = tid & 3;
    const u16* zp = PR + (size_t)(t0 + t) * 3072 + c0 + cpart * 16;
    V8 z0, z1; z0.u4 = *(const uint4*)zp; z1.u4 = *(const uint4*)(zp + 8);
    V8 o0, o1;
#pragma unroll
    for (int e = 0; e < 8; ++e) {
      o0.h[e] = f2bf(bf2f(tile[(cpart * 16 + e) * 72 + t]) * siluf_(bf2f(z0.h[e])));
      o1.h[e] = f2bf(bf2f(tile[(cpart * 16 + 8 + e) * 72 + t]) * siluf_(bf2f(z1.h[e])));
    }
    u16* yp = Y + (size_t)(t0 + t) * 2048 + c0 + cpart * 16;
    *(uint4*)yp = o0.u4;
    *(uint4*)(yp + 8) = o1.u4;
  }
}

__global__ void __launch_bounds__(256, 2) mega(Params p, int ph0, int ph1) {
  extern __shared__ __attribute__((aligned(16))) char smem[];
  __shared__ uint4 xb_words;
  cg::grid_group grid = cg::this_grid();
  if (threadIdx.x == 0) xb_words = make_uint4(0u, 0u, 0u, 0u);
  __syncthreads();
  XcdBarrier xb = xcd_barrier_post(p.bar, (volatile LAS unsigned*)&xb_words);
  const int vb = blockIdx.x, G = gridDim.x;
  for (int ph = ph0; ph < ph1; ++ph) {
    if (ph == 0) {
      for (int u = vb; u < 10048; u += G) {
        if (u < 1152) p0_hyf(p, u, smem);
        else if (u < 1536) p0_mod(p, u - 1152, smem);
        else p0_trans(p, u - 1536, smem);
      }
    } else if (ph == NPHASE - 1) {
      final_norm(p, vb, G);
    } else {
      const int layer = (ph - 1) / 5, sub = (ph - 1) % 5, li = layer >> 1;
      const bool ab = (layer & 1) == 0;
      const float* xp = layer == 0 ? p.x_prompt : p.out;
      const float* xs = layer == 0 ? p.x_sample : p.out + (size_t)TCTX * 1024;
      if (sub == 0) {
        norm_rows(p, layer, xp, xs, vb, G);
      } else if (sub == 1) {
        if (ab) {
          const u16* Bt = p.wab_in + (size_t)li * NPAB * 1024;
          for (int i = 0;; ++i) {
            const int seq = (i * 8 + (vb & 7)) * (G >> 3) + (vb >> 3);
            if (seq >= 96 * 48) break;
            const int panel = seq / (8 * 48), rem = seq - panel * (8 * 48);
            gemm_big<0>(p, p.H, Bt, (panel * 8 + ((rem >> 3) & 7)) * 256, ((rem >> 6) * 8 + (rem & 7)) * 128, smem);
          }
          for (int t = vb; t < 96; t += G) gemm_thin(p, p.H, Bt, t * 256, smem);
        } else {
          const u16* Bt = p.wcd_in + (size_t)li * 6144 * 1024;
          for (int i = 0;; ++i) {
            const int seq = (i * 8 + (vb & 7)) * (G >> 3) + (vb >> 3);
            if (seq >= 96 * 48) break;
            const int panel = seq / (8 * 48), rem = seq - panel * (8 * 48);
            gemm_big<1>(p, p.H, Bt, (panel * 8 + ((rem >> 3) & 7)) * 256, ((rem >> 6) * 8 + (rem & 7)) * 128, smem);
          }
        }
      } else if (sub == 2) {
        if (ab) {
          for (int u = vb; u < 2560; u += G) {
            const int r = u % G, base = u - r;
            const int v = G == 512 ? base + 64 * (r & 7) + (r >> 3) : u;
            gla_unit(p, li, v < 512 ? v : 512 + ((v - 512) ^ 32), smem);
          }
        } else {
          const int nk_ = (5120 - vb + G - 1) / G;
          for (int k_ = 0; k_ < nk_; ++k_) {
            const int u = vb + (((vb >> 3) & 1) ? nk_ - 1 - k_ : k_) * G;
            if (u < 1024) conv_unit<1>(p, li, u, smem);
            else if (u < 2048) conv_unit<0>(p, li, u - 1024, smem);
            else lrua_unit(p, li, u - 2048, smem);
          }
        }
      } else if (sub == 3) {
        if (ab) headnorm_rows(p, li, vb, G);
        else {
          for (int u = vb; u < 384 + 6144; u += G) {
            if (u < 256) lrub_unit<2>(p, li, G == 512 ? 32 * (u & 7) + (u >> 3) : u, smem);
            else if (u < 384) lrub_unit<5>(p, li, u - 256, smem);
            else c2_trans_unit(p, u - 384, smem);
          }
        }
      } else {
        const u16* A = ab ? p.R2 : p.R1;
        const u16* Bt = (ab ? p.wab_out : p.wcd_out) + (size_t)li * 1024 * 2048;
        if (G == 512) {
          const int seq = (vb & 7) * 64 + (vb >> 3);
          const int panel = seq >> 6, rem = seq & 63;
          gemm_big<2>(p, A, Bt, (panel * 8 + (rem >> 3)) * 256, (rem & 7) * 128, smem, 2048, layer, xp, xs);
          gemm_tile<2>(p, A, 2048, Bt, 2048, 16384 + (panel * 8 + (rem >> 3)) * 128, (rem & 7) * 128, layer, xp, xs, smem, p.out);
        } else {
          for (int i = 0;; ++i) {
            const int seq = (i * 8 + (vb & 7)) * (G >> 3) + (vb >> 3);
            if (seq >= 192 * 8) break;
            const int panel = seq / 64, rem = seq - panel * 64;
            gemm_tile<2>(p, A, 2048, Bt, 2048, (panel * 8 + (rem & 7)) * 128, (rem >> 3) * 128, layer, xp, xs, smem, p.out);
          }
        }
      }
    }
    if (ph + 1 < ph1) {
      if (ph1 > NPHASE) grid.sync();
      xcd_barrier(xb);
    }
  }
}

extern "C" void kernel_launch(void* const* d_in, const int* in_sizes, int n_in, void* d_out, int out_size, void* d_ws,
                              size_t ws_size, hipStream_t stream) {
  static int grid_blocks = 0;
  if (!grid_blocks) {
    int dev = 0, cus = 0, per_cu = 0;
    hipGetDevice(&dev);
    hipDeviceGetAttribute(&cus, hipDeviceAttributeMultiprocessorCount, dev);
    hipFuncSetAttribute((const void*)mega, hipFuncAttributeMaxDynamicSharedMemorySize, SMEM_BYTES);
    hipOccupancyMaxActiveBlocksPerMultiprocessor(&per_cu, mega, 256, SMEM_BYTES);
    if (per_cu > 2) per_cu = 2;
    if (per_cu < 1) per_cu = 1;
    grid_blocks = cus * per_cu;
  }
  Params p{};
  const float** pf = (const float**)&p;
  for (int i = 0; i < 36; ++i) pf[i] = (const float*)d_in[i];
  p.out = (float*)d_out;
  char* ws = (char*)d_ws;
  size_t off = 0;
  auto take = [&](size_t bytes) { char* r = ws + off; off += (bytes + 255) & ~(size_t)255; return r; };
  p.mod = (float*)take((size_t)4 * 9 * 3072 * 4);
  p.ga32 = (float*)take((size_t)TTOT * 32 * 4);
  p.wab_in = (u16*)take((size_t)2 * NPAB * 1024 * 2);
  p.wab_out = (u16*)take((size_t)2 * 1024 * 2048 * 2);
  p.wcd_in = (u16*)take((size_t)2 * 6144 * 1024 * 2);
  p.wcd_out = (u16*)take((size_t)2 * 1024 * 2048 * 2);
  p.wlru = (u16*)take((size_t)64 * 16384 * 2);
  p.hrev = (u16*)take((size_t)2 * 9437184 * 2);
  p.H = (u16*)take((size_t)TTOT * 1024 * 2);
  p.R1 = (u16*)take((size_t)TTOT * NPAB * 2);
  p.R2 = (u16*)take((size_t)TTOT * 2048 * 2);
  p.R3 = (u16*)take((size_t)TTOT * 2048 * 2);
  p.bar = (unsigned*)take((size_t)XCD_BAR_WORDS * 4);
  hipMemsetAsync(p.bar, 0, (size_t)XCD_BAR_WORDS * 4, stream);
  p.pseg = (float*)take((size_t)2 * (TTOT / 32) * 1024 * 4);
  p.hseg = (float*)take((size_t)2 * (TTOT / 32) * 1024 * 4);
  int ph0 = 0, ph1 = NPHASE;
#ifdef MULTI
  for (int ph = 0; ph < NPHASE; ++ph) {
    ph0 = ph; ph1 = ph + 1;
    void* args[] = {&p, &ph0, &ph1};
    hipLaunchCooperativeKernel((void*)mega, dim3(grid_blocks), dim3(256), args, SMEM_BYTES, stream);
  }
#else
  void* args[] = {&p, &ph0, &ph1};
  hipError_t e = hipLaunchCooperativeKernel((void*)mega, dim3(grid_blocks), dim3(256), args, SMEM_BYTES, stream);
  if (e != hipSuccess) fprintf(stderr, "cooperative launch failed: %s (grid %d)\n", hipGetErrorString(e), grid_blocks);
#endif
}
```

```cpp
#include <hip/hip_runtime.h>
#include <hip/hip_cooperative_groups.h>
#include <cstdio>
namespace cg = cooperative_groups;

typedef unsigned short u16;
using bf16x8 = __attribute__((ext_vector_type(8))) short;
using f32x4 = __attribute__((ext_vector_type(4))) float;
union V8 { bf16x8 v; uint4 u4; uint2 u2[2]; unsigned w[4]; u16 h[8]; };

#define TTOT 24576
#define TCTX 8192
#define NPAB 6272
#define OFF_GLA 25165824
#define OFF_RET 41943040
#define OFF_LRU 58720256
#define SMEM_BYTES 77824
#define NPHASE 22

struct Params {
  const float *x_prompt, *x_sample, *c, *state_gla, *state_ret, *state_lru, *c_ctx, *norm_g, *w_mod, *b_mod,
      *ab_w_in, *ab_gate_w2, *ab_gate_b, *ab_head_g, *ab_w_out, *cd_w_in, *hy_short_w, *hy_short_b,
      *hy_w1, *hy_b1, *hy_freq1, *hy_w2, *hy_b2, *hy_freq2, *hy_w3, *hy_b3, *hy_skip, *lru_conv_w,
      *lru_conv_b, *lru_w_r, *lru_b_r, *lru_w_i, *lru_b_i, *lru_lambda, *cd_w_out, *final_g;
  float* out;
  float* mod;
  float* ga32;
  u16 *wab_in, *wab_out, *wcd_in, *wcd_out, *wlru, *hrev, *H, *R1, *R2, *R3;
  unsigned* bar;
  float *pseg, *hseg;
};

typedef __bf16 bf2_t __attribute__((ext_vector_type(2)));
typedef float f2_t __attribute__((ext_vector_type(2)));
__device__ __forceinline__ unsigned pack2(float a, float b) {
  f2_t v = {a, b};
  return __builtin_bit_cast(unsigned, __builtin_convertvector(v, bf2_t));
}
__device__ __forceinline__ u16 f2bf(float f) { return (u16)(pack2(f, f) & 0xffffu); }
__device__ __forceinline__ float bf2f(u16 h) { return __uint_as_float(((unsigned)h) << 16); }
__device__ __forceinline__ float bflo(unsigned w) { return __uint_as_float(w << 16); }
__device__ __forceinline__ float bfhi(unsigned w) { return __uint_as_float(w & 0xffff0000u); }
__device__ __forceinline__ int cidx_of(int t) { return t < TCTX ? 0 : 1 + ((t - TCTX) >> 11); }
__device__ __forceinline__ float wave_sum(float v) {
#pragma unroll
  for (int off = 32; off > 0; off >>= 1) v += __shfl_xor(v, off);
  return v;
}
__device__ __forceinline__ float sigmoidf_(float x) { return __builtin_amdgcn_rcpf(1.f + __expf(-x)); }
__device__ __forceinline__ float siluf_(float x) { return x * __builtin_amdgcn_rcpf(1.f + __expf(-x)); }
__device__ __forceinline__ int tid_opaque() { int t = threadIdx.x; asm volatile("" : "+v"(t)); return t; }
typedef __attribute__((address_space(3))) void* lds_ptr_t;
typedef const __attribute__((address_space(1))) void* gbl_ptr_t;
#define MFMA(a, b, c) __builtin_amdgcn_mfma_f32_16x16x32_bf16((a), (b), (c), 0, 0, 0)

__device__ __forceinline__ size_t hrev_off(int li, int grp, int o, int c) {
  size_t base = (size_t)li * 9437184u;
  if (grp == 0) return base + (size_t)(o * 1024 + c) * 512;
  return base + 1048576u + (size_t)(o * 1024 + c) * 4096;
}


#define XB_TMO      128
#define XB_XCNT(j)  (256  + 64 * (j))
#define XB_XSUB(j)  (1280 + 64 * (j))
#define XB_XGEN(j)  (2304 + 64 * (j))
#define XB_TOP      3328
#define XB_TOPGEN   3392
#define XCD_BAR_WORDS 3456
#define XB_SPIN_CAP (1u << 20)
#define LAS __attribute__((address_space(3)))
__device__ __forceinline__ unsigned xb_ld(unsigned* p) { return __hip_atomic_load(p, __ATOMIC_RELAXED, __HIP_MEMORY_SCOPE_AGENT); }
__device__ __forceinline__ unsigned xb_add(unsigned* p, unsigned v) { return __hip_atomic_fetch_add(p, v, __ATOMIC_RELAXED, __HIP_MEMORY_SCOPE_AGENT); }
__device__ __forceinline__ unsigned xb_xcc_id() { return (unsigned)__builtin_amdgcn_s_getreg((3 << 11) | 20) & 0xFu; }
#define XB_SPIN(cond, bar) do { unsigned _sp = 0; while (cond) { __builtin_amdgcn_s_sleep(1); \
    if ((++_sp & 255u) == 0u) { if (xb_ld(&(bar)[XB_TMO])) break; if (_sp > XB_SPIN_CAP) { atomicAdd(&(bar)[XB_TMO], 1u); break; } } } } while (0)
struct XcdBarrier { unsigned* bar; unsigned x; volatile LAS unsigned* st; };
__device__ __forceinline__ XcdBarrier xcd_barrier_post(unsigned* bar, volatile LAS unsigned* st) {
  XcdBarrier b; b.bar = bar; b.x = xb_xcc_id(); b.st = st;
  if (threadIdx.x == 0) (void)xb_add(&bar[XB_XCNT(b.x)], 1u);
  return b;
}
__device__ __forceinline__ void xcd_barrier_complete(unsigned* bar, unsigned x, unsigned& nloc, unsigned& nx) {
  const unsigned G = gridDim.x * gridDim.y * gridDim.z;
  unsigned sum, cnt, mine, sp = 0u;
  for (;;) {
    sum = 0u; cnt = 0u; mine = 0u;
#pragma unroll
    for (unsigned j = 0; j < 16; ++j) { const unsigned c = xb_ld(&bar[XB_XCNT(j)]); sum += c; cnt += (c > 0u) ? 1u : 0u; mine = (j == x) ? c : mine; }
    if (sum == G) break;
    __builtin_amdgcn_s_sleep(1);
    if ((++sp & 255u) == 0u) { if (xb_ld(&bar[XB_TMO])) break; if (sp > XB_SPIN_CAP) { atomicAdd(&bar[XB_TMO], 1u); break; } }
  }
  nloc = mine > 0u ? mine : 1u; nx = cnt > 0u ? cnt : 1u;
}
__device__ __forceinline__ void xcd_barrier(const XcdBarrier& b) {
  asm volatile("s_waitcnt vmcnt(0)" ::: "memory");
  __syncthreads();
  if (threadIdx.x == 0) {
    unsigned* bar = b.bar;
    __builtin_amdgcn_s_waitcnt(0);
    unsigned nloc = b.st[0], nx = b.st[1];
    if (nloc == 0u) { xcd_barrier_complete(bar, b.x, nloc, nx); b.st[0] = nloc; b.st[1] = nx; }
    const unsigned old = xb_add(&bar[XB_XSUB(b.x)], 1u);
    const unsigned gen = old / nloc;
    if (old + 1u == (gen + 1u) * nloc) {
      __builtin_amdgcn_fence(__ATOMIC_RELEASE, "agent");
      asm volatile("s_waitcnt vmcnt(0)" ::: "memory");
      const unsigned og = xb_add(&bar[XB_TOP], 1u);
      const unsigned tg = og / nx;
      if (og + 1u == (tg + 1u) * nx) xb_add(&bar[XB_TOPGEN], 1u);
      else XB_SPIN(xb_ld(&bar[XB_TOPGEN]) == tg, bar);
      __builtin_amdgcn_fence(__ATOMIC_ACQUIRE, "agent");
      xb_add(&bar[XB_XGEN(b.x)], 1u);
      asm volatile("s_waitcnt vmcnt(0)" ::: "memory");
    } else {
      XB_SPIN(xb_ld(&bar[XB_XGEN(b.x)]) == gen, bar);
      __builtin_amdgcn_fence(__ATOMIC_ACQUIRE, "agent");
      asm volatile("s_waitcnt vmcnt(0)" ::: "memory");
    }
  }
  __syncthreads();
}

__device__ void p0_mod(const Params& p, int u, char* smem) {
  float* sc = (float*)smem;
  float* red = sc + 9 * 1024;
  const int tid = tid_opaque();
  const int layer = u / 96, col0 = (u % 96) * 32;
  __syncthreads();
#pragma unroll 1
  for (int i0 = 0; i0 < 36; i0 += 9) {
    float v[9];
#pragma unroll
    for (int i = 0; i < 9; ++i) {
      const int idx = tid + 256 * (i0 + i), ci = idx >> 10, k = idx & 1023;
      v[i] = ci == 0 ? p.c_ctx[k] : p.c[(ci - 1) * 1024 + k];
    }
#pragma unroll
    for (int i = 0; i < 9; ++i) sc[tid + 256 * (i0 + i)] = v[i] * __builtin_amdgcn_rcpf(1.f + __expf(-v[i]));
  }
  __syncthreads();
  const int col = tid & 31, kg = tid >> 5;
  float acc[9];
#pragma unroll
  for (int ci = 0; ci < 9; ++ci) acc[ci] = 0.f;
  const float* wp = p.w_mod + (size_t)layer * 1024 * 3072 + col0 + col;
#pragma unroll 1
  for (int k0 = kg * 128; k0 < kg * 128 + 128; k0 += 16) {
    float wv[16];
#pragma unroll
    for (int i = 0; i < 16; ++i) wv[i] = wp[(size_t)(k0 + i) * 3072];
#pragma unroll
    for (int i = 0; i < 16; ++i)
#pragma unroll
      for (int ci = 0; ci < 9; ++ci) acc[ci] += sc[ci * 1024 + k0 + i] * wv[i];
  }
#pragma unroll
  for (int ci = 0; ci < 9; ++ci) red[(kg * 9 + ci) * 32 + col] = acc[ci];
  __syncthreads();
  for (int idx = tid; idx < 288; idx += 256) {
    int ci = idx >> 5, cc = idx & 31;
    float v = p.b_mod[layer * 3072 + col0 + cc];
#pragma unroll
    for (int g = 0; g < 8; ++g) v += red[(g * 9 + ci) * 32 + cc];
    p.mod[(layer * 9 + ci) * 3072 + col0 + cc] = v;
  }
}

__device__ void p0_trans_tile(const float* __restrict__ src, int N, u16* __restrict__ dst, int K, int k0, int n0,
                              char* smem) {
  float* tile = (float*)smem;
  const int tid = tid_opaque();
  __syncthreads();
  {
    float4 v[4];
#pragma unroll
    for (int i = 0; i < 4; ++i) {
      const int id = tid + 256 * i, kk = id >> 4, c4 = id & 15;
      const int n = n0 + c4 * 4;
      v[i] = n < N ? *(const float4*)(src + (size_t)(k0 + kk) * N + n) : make_float4(0.f, 0.f, 0.f, 0.f);
    }
#pragma unroll
    for (int i = 0; i < 4; ++i) {
      const int id = tid + 256 * i, kk = id >> 4, c4 = id & 15;
      float* t = tile + kk * 65 + c4 * 4;
      t[0] = v[i].x; t[1] = v[i].y; t[2] = v[i].z; t[3] = v[i].w;
    }
  }
  __syncthreads();
#pragma unroll
  for (int i = 0; i < 2; ++i) {
    const int id = tid + 256 * i, nn = id >> 3, kc = id & 7;
    const float* t = tile + (kc * 8) * 65 + nn;
    uint4 o;
    o.x = pack2(t[0], t[65]); o.y = pack2(t[130], t[195]); o.z = pack2(t[260], t[325]); o.w = pack2(t[390], t[455]);
    *(uint4*)(dst + (size_t)(n0 + nn) * K + k0 + kc * 8) = o;
  }
}

__device__ void p0_trans(const Params& p, int u, char* smem) {
  if (u < 3136) {
    int lay = u / 1568, r = u % 1568, kt = r / 98, nt = r % 98;
    p0_trans_tile(p.ab_w_in + (size_t)lay * 1024 * 6176, 6176, p.wab_in + (size_t)lay * NPAB * 1024, 1024, kt * 64,
                  nt * 64, smem);
  } else if (u < 4160) {
    int v = u - 3136, lay = v / 512, r = v % 512, kt = r / 16, nt = r % 16;
    p0_trans_tile(p.ab_w_out + (size_t)lay * 2048 * 1024, 1024, p.wab_out + (size_t)lay * 1024 * 2048, 2048, kt * 64,
                  nt * 64, smem);
  } else if (u < 7232) {
    int v = u - 4160, lay = v / 1536, r = v % 1536, kt = r / 96, nt = r % 96;
    p0_trans_tile(p.cd_w_in + (size_t)lay * 1024 * 6144, 6144, p.wcd_in + (size_t)lay * 6144 * 1024, 1024, kt * 64,
                  nt * 64, smem);
  } else if (u < 8256) {
    int v = u - 7232, lay = v / 512, r = v % 512, kt = r / 16, nt = r % 16;
    p0_trans_tile(p.cd_w_out + (size_t)lay * 2048 * 1024, 1024, p.wcd_out + (size_t)lay * 1024 * 2048, 2048, kt * 64,
                  nt * 64, smem);
  } else {
    int v = u - 8256, ri = v / 128, r = v % 128, mat = r / 4, t4 = r % 4, kt = t4 / 2, nt = t4 % 2;
    p0_trans_tile((ri ? p.lru_w_i : p.lru_w_r) + (size_t)mat * 16384, 128, p.wlru + (size_t)(mat * 2 + ri) * 16384,
                  128, kt * 64, nt * 64, smem);
  }
}

__device__ void p0_hyf(const Params& p, int u, char* smem) {
  float* g1s = (float*)smem;
  float* g2s = g1s + 4096;
  float* fts = g2s + 4096;
  const int tid = tid_opaque();
  const int li = u / 576;
  int r = u % 576, grp, ptile, ctile;
  if (r < 64) { grp = 0; ptile = r / 16; ctile = r % 16; }
  else { grp = 1; r -= 64; ptile = r / 16; ctile = r % 16; }
  const int L = grp ? 2048 : 256;
  const int pl = tid & 63;
  const int hg = __builtin_amdgcn_readfirstlane(tid >> 6);
  const int pg = ptile * 64 + pl;
  const float tpos = (float)pg / (float)(L - 1);
  __syncthreads();
  for (int f = hg; f < 33; f += 4) {
    float v;
    if (f == 0) v = tpos;
    else {
      const int bi = (f - 1) & 15;
      const float fb = 1e-4f + (float)bi * ((15.f - 1e-4f) / 15.f);
      float turns = (float)pg * fb * (1.f / (float)L);
      turns -= floorf(turns);
      const float ang = 6.283185307179586f * turns;
      v = f <= 16 ? __cosf(ang) : -__sinf(ang);
    }
    fts[f * 64 + pl] = v;
  }
  __syncthreads();
#pragma unroll 1
  for (int hh = 0; hh < 16; ++hh) {
    const int h = hg * 16 + hh;
    float s = p.hy_b1[li * 64 + h];
#pragma unroll 11
    for (int f = 0; f < 33; ++f) s += fts[f * 64 + pl] * p.hy_w1[(li * 33 + f) * 64 + h];
    g1s[h * 64 + pl] = __sinf(p.hy_freq1[li * 64 + h] * s);
  }
  __syncthreads();
#pragma unroll 1
  for (int hh = 0; hh < 16; ++hh) {
    const int h2 = hg * 16 + hh;
    float s = p.hy_b2[li * 64 + h2];
#pragma unroll 16
    for (int h = 0; h < 64; ++h) s += g1s[h * 64 + pl] * p.hy_w2[(li * 64 + h) * 64 + h2];
    g2s[h2 * 64 + pl] = __sinf(p.hy_freq2[li * 64 + h2] * s);
  }
  __syncthreads();
  float center[16];
#pragma unroll
  for (int cc = 0; cc < 16; ++cc) center[cc] = 0.f;
  const float A0 = -15.350567286626973f, A1 = -3.0701134573253945f;
#pragma unroll 1
  for (int f = 0; f < 4; ++f) {
    const int cb = f * 1024 + ctile * 64 + hg * 16;
    float a16[16];
#pragma unroll
    for (int cc = 0; cc < 16; ++cc) a16[cc] = p.hy_b3[li * 4096 + cb + cc];
    const float* w3 = p.hy_w3 + (size_t)li * 64 * 4096 + cb;
#pragma unroll 4
    for (int j = 0; j < 64; ++j) {
      const float g = g2s[j * 64 + pl];
#pragma unroll
      for (int cc = 0; cc < 16; ++cc) a16[cc] += g * w3[(size_t)j * 4096 + cc];
    }
    const int o = f >> 1;
#pragma unroll
    for (int cc = 0; cc < 16; ++cc) {
      const int c = ctile * 64 + hg * 16 + cc;
      const float delta = fabsf(A0 + (float)c * ((A1 - A0) / 1023.f));
      const float val = a16[cc] * __expf(-tpos * delta);
      u16* hr = p.hrev + hrev_off(li, grp, o, c);
      if (!(f & 1)) {
        if (pg == 0) { center[cc] = val; hr[0] = 0; }
        else hr[L - pg] = f2bf(val);
      } else {
        if (pg == 0) hr[L] = f2bf(center[cc] + val + p.hy_skip[(li * 2 + o) * 1024 + c]);
        else hr[L + pg] = f2bf(val);
      }
    }
  }
}

__device__ void norm_rows(const Params& p, int layer, const float* xp, const float* xs, int vb, int G) {
  const int tid_ = tid_opaque(); const int wave = tid_ >> 6, lane = tid_ & 63;
  for (int row = vb * 4 + wave; row < TTOT; row += G * 4) {
    const float* xr = row < TCTX ? xp + (size_t)row * 1024 : xs + (size_t)(row - TCTX) * 1024;
    float4 v[4];
    float ss = 0.f;
#pragma unroll
    for (int j = 0; j < 4; ++j) {
      v[j] = *(const float4*)(xr + j * 256 + lane * 4);
      ss += v[j].x * v[j].x + v[j].y * v[j].y + v[j].z * v[j].z + v[j].w * v[j].w;
    }
    ss = wave_sum(ss);
    const float rstd = rsqrtf(ss * (1.f / 1024.f) + 1e-6f);
    const float* md = p.mod + (size_t)(layer * 9 + cidx_of(row)) * 3072;
    const float* g = p.norm_g + layer * 1024;
#pragma unroll
    for (int j = 0; j < 4; ++j) {
      int col = j * 256 + lane * 4;
      float4 gg = *(const float4*)(g + col), sh = *(const float4*)(md + col), sl = *(const float4*)(md + 1024 + col);
      float h0 = v[j].x * rstd * gg.x * (1.f + sl.x) + sh.x;
      float h1 = v[j].y * rstd * gg.y * (1.f + sl.y) + sh.y;
      float h2 = v[j].z * rstd * gg.z * (1.f + sl.z) + sh.z;
      float h3 = v[j].w * rstd * gg.w * (1.f + sl.w) + sh.w;
      uint2 o; o.x = pack2(h0, h1); o.y = pack2(h2, h3);
      *(uint2*)(p.H + (size_t)row * 1024 + col) = o;
    }
  }
}

__device__ void final_norm(const Params& p, int vb, int G) {
  const int tid_ = tid_opaque(); const int wave = tid_ >> 6, lane = tid_ & 63;
  for (int row = vb * 4 + wave; row < TTOT; row += G * 4) {
    float* xr = p.out + (size_t)row * 1024;
    float4 v[4];
    float ss = 0.f;
#pragma unroll
    for (int j = 0; j < 4; ++j) {
      v[j] = *(const float4*)(xr + j * 256 + lane * 4);
      ss += v[j].x * v[j].x + v[j].y * v[j].y + v[j].z * v[j].z + v[j].w * v[j].w;
    }
    ss = wave_sum(ss);
    const float rstd = rsqrtf(ss * (1.f / 1024.f) + 1e-6f);
#pragma unroll
    for (int j = 0; j < 4; ++j) {
      int col = j * 256 + lane * 4;
      float4 gg = *(const float4*)(p.final_g + col);
      float4 o;
      o.x = v[j].x * rstd * gg.x; o.y = v[j].y * rstd * gg.y; o.z = v[j].z * rstd * gg.z; o.w = v[j].w * rstd * gg.w;
      *(float4*)(xr + col) = o;
    }
  }
}

__device__ void headnorm_rows(const Params& p, int li, int vb, int G) {
  const int tid_ = tid_opaque(); const int wave = tid_ >> 6, lane = tid_ & 63;
  u16* OF = p.R2; const u16* OB = p.R3; const u16* PROJ = p.R1;
  const int stride = G * 4;
  for (int item0 = vb * 4 + wave; item0 < TTOT * 8; item0 += 4 * stride) {
    uint2 a[4], b[4], z[4];
#pragma unroll
    for (int k = 0; k < 4; ++k) {
      const int item = item0 + k * stride;
      if (item < TTOT * 8) {
        const int t = item >> 3, hh = item & 7;
        const int col0 = hh * 256 + lane * 4;
        const int zc = (hh < 4 ? 2080 + hh * 256 : 5152 + (hh - 4) * 256) + lane * 4;
        a[k] = *(const uint2*)(OF + (size_t)t * 2048 + col0);
        b[k] = *(const uint2*)(OB + (size_t)t * 2048 + col0);
        z[k] = *(const uint2*)(PROJ + (size_t)t * NPAB + zc);
      } else { a[k] = make_uint2(0, 0); b[k] = a[k]; z[k] = a[k]; }
    }
#pragma unroll
    for (int k = 0; k < 4; ++k) {
      const int item = item0 + k * stride;
      if (item >= TTOT * 8) break;
      const int t = item >> 3, hh = item & 7;
      const int col0 = hh * 256 + lane * 4;
      float o0 = bflo(a[k].x) + bflo(b[k].x), o1 = bfhi(a[k].x) + bfhi(b[k].x);
      float o2 = bflo(a[k].y) + bflo(b[k].y), o3 = bfhi(a[k].y) + bfhi(b[k].y);
      if (hh >= 4) {
        float m = wave_sum(o0 + o1 + o2 + o3) * (1.f / 256.f);
        o0 -= m; o1 -= m; o2 -= m; o3 -= m;
      }
      float ss = wave_sum(o0 * o0 + o1 * o1 + o2 * o2 + o3 * o3) * (1.f / 256.f);
      const float rstd = rsqrtf(ss + 1e-6f);
      float4 g = *(const float4*)(p.ab_head_g + li * 2048 + col0);
      float y0 = o0 * rstd * g.x * siluf_(bflo(z[k].x));
      float y1 = o1 * rstd * g.y * siluf_(bfhi(z[k].x));
      float y2 = o2 * rstd * g.z * siluf_(bflo(z[k].y));
      float y3 = o3 * rstd * g.w * siluf_(bfhi(z[k].y));
      uint2 y; y.x = pack2(y0, y1); y.y = pack2(y2, y3);
      *(uint2*)(OF + (size_t)t * 2048 + col0) = y;
    }
  }
}

template <int MODE>
__device__ __forceinline__ void gemm_tile(const Params& p, const u16* __restrict__ A, int lda,
                                          const u16* __restrict__ Bt, int K, int m0, int n0, int layer,
                                          const float* xp, const float* xs, char* smem, float* xdst = nullptr) {
  const int tid = tid_opaque(), lane = tid & 63, w = tid >> 6, l = lane & 15, q = lane >> 4;
  const int wm = w >> 1, wn = w & 1;
  f32x4 acc[4][4];
#pragma unroll
  for (int mi = 0; mi < 4; ++mi)
#pragma unroll
    for (int ni = 0; ni < 4; ++ni) acc[mi][ni] = (f32x4){0.f, 0.f, 0.f, 0.f};
  const int nk = K >> 5;
  const int r0 = tid >> 2, c0 = (tid & 3) ^ ((-(r0 >> 2)) & 3);
  const int r1 = 64 + r0;
  const u16* ga0 = A + (size_t)(m0 + r0) * lda + c0 * 8;
  const u16* ga1 = A + (size_t)(m0 + r1) * lda + c0 * 8;
  const u16* gb0 = Bt + (size_t)(n0 + r0) * K + c0 * 8;
  const u16* gb1 = Bt + (size_t)(n0 + r1) * K + c0 * 8;
  char* ldst = smem + tid * 16;
#define GISSUE(KT)                                                                                         \
  {                                                                                                        \
    char* st_ = ldst + ((KT) & 3) * 16384;                                                                 \
    const int ko_ = (KT) * 32;                                                                             \
    __builtin_amdgcn_global_load_lds((gbl_ptr_t)(ga0 + ko_), (lds_ptr_t)(st_), 16, 0, 0);                  \
    __builtin_amdgcn_global_load_lds((gbl_ptr_t)(ga1 + ko_), (lds_ptr_t)(st_ + 4096), 16, 0, 0);           \
    __builtin_amdgcn_global_load_lds((gbl_ptr_t)(gb0 + ko_), (lds_ptr_t)(st_ + 8192), 16, 0, 0);           \
    __builtin_amdgcn_global_load_lds((gbl_ptr_t)(gb1 + ko_), (lds_ptr_t)(st_ + 12288), 16, 0, 0);          \
  }
  GISSUE(0)
  GISSUE(1)
  GISSUE(2)
  const int aoff = (wm * 64 + l) * 64 + ((q ^ ((-(l >> 2)) & 3)) * 16);
  const int boff = 8192 + (wn * 64 + l) * 64 + ((q ^ ((-(l >> 2)) & 3)) * 16);
  bf16x8 a0[4], b0[4], a1[4], b1[4];
#define GWAIT(KT)                                                            \
  if ((KT) + 2 < nk) asm volatile("s_waitcnt vmcnt(8)" ::: "memory");        \
  else if ((KT) + 1 < nk) asm volatile("s_waitcnt vmcnt(4)" ::: "memory");   \
  else asm volatile("s_waitcnt vmcnt(0)" ::: "memory");                      \
  __builtin_amdgcn_s_barrier();
#define GREAD(KT, AF, BF)                                                    \
  {                                                                          \
    const char* st_ = smem + ((KT) & 3) * 16384;                             \
    _Pragma("unroll") for (int mi = 0; mi < 4; ++mi) AF[mi] = *(const bf16x8*)(st_ + aoff + mi * 1024); \
    _Pragma("unroll") for (int ni = 0; ni < 4; ++ni) BF[ni] = *(const bf16x8*)(st_ + boff + ni * 1024); \
  }
#define GMMA(AF, BF)                                                         \
  _Pragma("unroll") for (int mi = 0; mi < 4; ++mi)                           \
  _Pragma("unroll") for (int ni = 0; ni < 4; ++ni) acc[mi][ni] = MFMA(AF[mi], BF[ni], acc[mi][ni]);
  GWAIT(0)
  GREAD(0, a0, b0)
#pragma unroll 1
  for (int kt = 0; kt < nk; kt += 2) {
    if (kt + 3 < nk) GISSUE(kt + 3)
    GWAIT(kt + 1)
    GREAD(kt + 1, a1, b1)
    GMMA(a0, b0)
    if (kt + 2 < nk) {
      if (kt + 4 < nk) GISSUE(kt + 4)
      GWAIT(kt + 2)
      GREAD(kt + 2, a0, b0)
    }
    GMMA(a1, b1)
  }
  __syncthreads();
  if (MODE == 2) {
    float* tile = (float*)smem;
#pragma unroll
    for (int mi = 0; mi < 4; ++mi)
#pragma unroll
      for (int ni = 0; ni < 4; ++ni)
#pragma unroll
        for (int r = 0; r < 4; ++r)
          tile[(wm * 64 + mi * 16 + q * 4 + r) * 132 + wn * 64 + ni * 16 + l] = acc[mi][ni][r];
    __syncthreads();
#pragma unroll 4
    for (int i = 0; i < 16; ++i) {
      const int id = tid + 256 * i, row = id >> 5, cc = id & 31;
      const int grow = m0 + row, gcol = n0 + cc * 4;
      const float4 v = *(const float4*)(tile + row * 132 + cc * 4);
      const float4 g = *(const float4*)(p.mod + (size_t)(layer * 9 + cidx_of(grow)) * 3072 + 2048 + gcol);
      const float* xr = grow < TCTX ? xp + (size_t)grow * 1024 + gcol : xs + (size_t)(grow - TCTX) * 1024 + gcol;
      const float4 xi = *(const float4*)xr;
      float4 o;
      o.x = xi.x + g.x * v.x; o.y = xi.y + g.y * v.y; o.z = xi.z + g.z * v.z; o.w = xi.w + g.w * v.w;
      *(float4*)(xdst + (size_t)grow * 1024 + gcol) = o;
    }
  } else if (MODE == 1 && n0 < 3072) {
    u16* tile = (u16*)smem;
#pragma unroll
    for (int mi = 0; mi < 4; ++mi)
#pragma unroll
      for (int ni = 0; ni < 4; ++ni) {
        uint2 o; o.x = pack2(acc[mi][ni][0], acc[mi][ni][1]); o.y = pack2(acc[mi][ni][2], acc[mi][ni][3]);
        *(uint2*)(tile + (wn * 64 + ni * 16 + l) * 136 + wm * 64 + mi * 16 + q * 4) = o;
      }
    __syncthreads();
#pragma unroll
    for (int i = 0; i < 8; ++i) {
      const int id = tid + 256 * i, col = id >> 4, cc = id & 15;
      *(uint4*)(p.R1 + (size_t)(n0 + col) * TTOT + m0 + cc * 8) = *(const uint4*)(tile + col * 136 + cc * 8);
    }
  } else {
    u16* tile = (u16*)smem;
#pragma unroll
    for (int mi = 0; mi < 4; ++mi)
#pragma unroll
      for (int ni = 0; ni < 4; ++ni)
#pragma unroll
        for (int r = 0; r < 4; ++r)
          tile[(wm * 64 + mi * 16 + q * 4 + r) * 136 + wn * 64 + ni * 16 + l] = f2bf(acc[mi][ni][r]);
    if (MODE == 0 && n0 == 2048 && wn == 0) {
#pragma unroll
      for (int mi = 0; mi < 4; ++mi)
#pragma unroll
        for (int ni = 0; ni < 2; ++ni)
#pragma unroll
          for (int r = 0; r < 4; ++r)
            p.ga32[(size_t)(m0 + wm * 64 + mi * 16 + q * 4 + r) * 32 + ni * 16 + l] = acc[mi][ni][r];
    }
    __syncthreads();
    u16* dst = MODE == 0 ? p.R1 + (size_t)m0 * NPAB + n0 : p.R1 + (size_t)3072 * TTOT + (size_t)m0 * 3072 + (n0 - 3072);
    const int ldd = MODE == 0 ? NPAB : 3072;
#pragma unroll
    for (int i = 0; i < 8; ++i) {
      const int id = tid + 256 * i, row = id >> 4, cc = id & 15;
      *(uint4*)(dst + (size_t)row * ldd + cc * 8) = *(const uint4*)(tile + row * 136 + cc * 8);
    }
  }
  __syncthreads();
}

template <int MODE>
__device__ __forceinline__ void gemm_big(const Params& p, const u16* __restrict__ A, const u16* __restrict__ Bt,
                                         int m0, int n0, char* smem, const int K = 1024, int layer = 0,
                                         const float* xp = nullptr, const float* xs = nullptr) {
  const int nk = K >> 5;
  const int tid = tid_opaque(), lane = tid & 63, w = tid >> 6, l = lane & 15, q = lane >> 4;
  const int wm = w >> 1, wn = w & 1;
  f32x4 acc[8][4];
#pragma unroll
  for (int mi = 0; mi < 8; ++mi)
#pragma unroll
    for (int ni = 0; ni < 4; ++ni) acc[mi][ni] = (f32x4){0.f, 0.f, 0.f, 0.f};
  const int r0 = tid >> 2, c0 = (tid & 3) ^ ((-(r0 >> 2)) & 3);
  const u16* ga = A + (size_t)(m0 + r0) * K + c0 * 8;
  const u16* gb = Bt + (size_t)(n0 + r0) * K + c0 * 8;
  const size_t r64 = (size_t)64 * K;
  char* ldst = smem + tid * 16;
#define BISSUE(KT, BUF)                                                                                      \
  {                                                                                                          \
    char* st_ = ldst + (BUF) * 24576;                                                                        \
    const int ko_ = (KT) * 32;                                                                               \
    __builtin_amdgcn_global_load_lds((gbl_ptr_t)(ga + ko_), (lds_ptr_t)(st_), 16, 0, 0);                     \
    __builtin_amdgcn_global_load_lds((gbl_ptr_t)(ga + r64 + ko_), (lds_ptr_t)(st_ + 4096), 16, 0, 0);      \
    __builtin_amdgcn_global_load_lds((gbl_ptr_t)(ga + 2 * r64 + ko_), (lds_ptr_t)(st_ + 8192), 16, 0, 0);     \
    __builtin_amdgcn_global_load_lds((gbl_ptr_t)(ga + 3 * r64 + ko_), (lds_ptr_t)(st_ + 12288), 16, 0, 0);    \
    __builtin_amdgcn_global_load_lds((gbl_ptr_t)(gb + ko_), (lds_ptr_t)(st_ + 16384), 16, 0, 0);             \
    __builtin_amdgcn_global_load_lds((gbl_ptr_t)(gb + r64 + ko_), (lds_ptr_t)(st_ + 20480), 16, 0, 0);     \
  }
  BISSUE(0, 0)
  BISSUE(1, 1)
  const int swz = (q ^ ((-(l >> 2)) & 3)) * 16;
  const int aoff = (wm * 128 + l) * 64 + swz;
  const int boff = 16384 + (wn * 64 + l) * 64 + swz;
  int buf = 0;
#pragma unroll 1
  for (int kt = 0; kt < nk; ++kt) {
    if (kt + 1 < nk) asm volatile("s_waitcnt vmcnt(6)" ::: "memory");
    else asm volatile("s_waitcnt vmcnt(0)" ::: "memory");
    __builtin_amdgcn_s_barrier();
    if (kt + 2 < nk) {
      const int nb = buf == 0 ? 2 : buf - 1;
      BISSUE(kt + 2, nb)
    }
    const char* st = smem + buf * 24576;
    bf16x8 b[4];
#pragma unroll
    for (int ni = 0; ni < 4; ++ni) b[ni] = *(const bf16x8*)(st + boff + ni * 1024);
#pragma unroll
    for (int mi = 0; mi < 8; ++mi) {
      const bf16x8 a = *(const bf16x8*)(st + aoff + mi * 1024);
#pragma unroll
      for (int ni = 0; ni < 4; ++ni) acc[mi][ni] = MFMA(a, b[ni], acc[mi][ni]);
    }
    buf = buf == 2 ? 0 : buf + 1;
  }
  __syncthreads();
  if (MODE == 2) {
    float* tile = (float*)smem;
#pragma unroll 1
    for (int h = 0; h < 2; ++h) {
      if (wm == h) {
#pragma unroll
        for (int mi = 0; mi < 8; ++mi)
#pragma unroll
          for (int ni = 0; ni < 4; ++ni)
#pragma unroll
            for (int r = 0; r < 4; ++r) tile[(mi * 16 + q * 4 + r) * 132 + wn * 64 + ni * 16 + l] = acc[mi][ni][r];
      }
      __syncthreads();
#pragma unroll 4
      for (int i = 0; i < 16; ++i) {
        const int id = tid + 256 * i, row = id >> 5, cc = id & 31;
        const int grow = m0 + h * 128 + row, gcol = n0 + cc * 4;
        const float4 v = *(const float4*)(tile + row * 132 + cc * 4);
        const float4 gg = *(const float4*)(p.mod + (size_t)(layer * 9 + cidx_of(grow)) * 3072 + 2048 + gcol);
        const float* xr = grow < TCTX ? xp + (size_t)grow * 1024 + gcol : xs + (size_t)(grow - TCTX) * 1024 + gcol;
        const float4 xi = *(const float4*)xr;
        float4 o;
        o.x = xi.x + gg.x * v.x; o.y = xi.y + gg.y * v.y; o.z = xi.z + gg.z * v.z; o.w = xi.w + gg.w * v.w;
        *(float4*)(p.out + (size_t)grow * 1024 + gcol) = o;
      }
      __syncthreads();
    }
    return;
  }
  if (MODE == 1 && n0 < 3072) {
    u16* tile = (u16*)smem;
#pragma unroll
    for (int mi = 0; mi < 8; ++mi)
#pragma unroll
      for (int ni = 0; ni < 4; ++ni) {
        uint2 o; o.x = pack2(acc[mi][ni][0], acc[mi][ni][1]); o.y = pack2(acc[mi][ni][2], acc[mi][ni][3]);
        *(uint2*)(tile + (wn * 64 + ni * 16 + l) * 264 + wm * 128 + mi * 16 + q * 4) = o;
      }
    __syncthreads();
#pragma unroll 4
    for (int i = 0; i < 16; ++i) {
      const int id = tid + 256 * i, col = id >> 5, cc = id & 31;
      *(uint4*)(p.R1 + (size_t)(n0 + col) * TTOT + m0 + cc * 8) = *(const uint4*)(tile + col * 264 + cc * 8);
    }
  } else {
    u16* tile = (u16*)smem;
#pragma unroll
    for (int mi = 0; mi < 8; ++mi)
#pragma unroll
      for (int ni = 0; ni < 4; ++ni)
#pragma unroll
        for (int r = 0; r < 4; ++r)
          tile[(wm * 128 + mi * 16 + q * 4 + r) * 136 + wn * 64 + ni * 16 + l] = f2bf(acc[mi][ni][r]);
    if (MODE == 0 && n0 == 2048 && wn == 0) {
#pragma unroll
      for (int mi = 0; mi < 8; ++mi)
#pragma unroll
        for (int ni = 0; ni < 2; ++ni)
#pragma unroll
          for (int r = 0; r < 4; ++r)
            p.ga32[(size_t)(m0 + wm * 128 + mi * 16 + q * 4 + r) * 32 + ni * 16 + l] = acc[mi][ni][r];
    }
    __syncthreads();
    u16* dst = MODE == 0 ? p.R1 + (size_t)m0 * NPAB + n0 : p.R1 + (size_t)3072 * TTOT + (size_t)m0 * 3072 + (n0 - 3072);
    const int ldd = MODE == 0 ? NPAB : 3072;
#pragma unroll 4
    for (int i = 0; i < 16; ++i) {
      const int id = tid + 256 * i, row = id >> 4, cc = id & 15;
      *(uint4*)(dst + (size_t)row * ldd + cc * 8) = *(const uint4*)(tile + row * 136 + cc * 8);
    }
  }
  __syncthreads();
}

__device__ __forceinline__ void gemm_thin(const Params& p, const u16* __restrict__ A, const u16* __restrict__ Bt,
                                          int m0, char* smem) {
  const int n0 = 6144;
  const int tid = tid_opaque(), lane = tid & 63, w = tid >> 6, l = lane & 15, q = lane >> 4;
  f32x4 acc[4][2];
#pragma unroll
  for (int mi = 0; mi < 4; ++mi)
#pragma unroll
    for (int ni = 0; ni < 2; ++ni) acc[mi][ni] = (f32x4){0.f, 0.f, 0.f, 0.f};
  const int r0 = tid >> 2, c0 = (tid & 3) ^ ((-(r0 >> 2)) & 3);
  const u16* ga = A + (size_t)(m0 + r0) * 1024 + c0 * 8;
  const u16* gb = Bt + (size_t)(n0 + (r0 & 31)) * 1024 + c0 * 8;
  char* ldst = smem + tid * 16;
  const bool bl = w < 2;
#define TISSUE(KT, BUF)                                                                                      \
  {                                                                                                          \
    char* st_ = ldst + (BUF) * 24576;                                                                        \
    const int ko_ = (KT) * 32;                                                                               \
    __builtin_amdgcn_global_load_lds((gbl_ptr_t)(ga + ko_), (lds_ptr_t)(st_), 16, 0, 0);                     \
    __builtin_amdgcn_global_load_lds((gbl_ptr_t)(ga + 65536 + ko_), (lds_ptr_t)(st_ + 4096), 16, 0, 0);      \
    __builtin_amdgcn_global_load_lds((gbl_ptr_t)(ga + 131072 + ko_), (lds_ptr_t)(st_ + 8192), 16, 0, 0);     \
    __builtin_amdgcn_global_load_lds((gbl_ptr_t)(ga + 196608 + ko_), (lds_ptr_t)(st_ + 12288), 16, 0, 0);    \
    if (bl) __builtin_amdgcn_global_load_lds((gbl_ptr_t)(gb + ko_), (lds_ptr_t)(st_ + 16384), 16, 0, 0);     \
  }
  TISSUE(0, 0)
  TISSUE(1, 1)
  const int swz = (q ^ ((-(l >> 2)) & 3)) * 16;
  const int aoff = (w * 64 + l) * 64 + swz;
  const int boff = 16384 + l * 64 + swz;
  int buf = 0;
#pragma unroll 1
  for (int kt = 0; kt < 32; ++kt) {
    if (kt + 1 < 32) {
      if (bl) asm volatile("s_waitcnt vmcnt(5)" ::: "memory");
      else asm volatile("s_waitcnt vmcnt(4)" ::: "memory");
    } else asm volatile("s_waitcnt vmcnt(0)" ::: "memory");
    __builtin_amdgcn_s_barrier();
    if (kt + 2 < 32) {
      const int nb = buf == 0 ? 2 : buf - 1;
      TISSUE(kt + 2, nb)
    }
    const char* st = smem + buf * 24576;
    bf16x8 b[2];
#pragma unroll
    for (int ni = 0; ni < 2; ++ni) b[ni] = *(const bf16x8*)(st + boff + ni * 1024);
#pragma unroll
    for (int mi = 0; mi < 4; ++mi) {
      const bf16x8 a = *(const bf16x8*)(st + aoff + mi * 1024);
#pragma unroll
      for (int ni = 0; ni < 2; ++ni) acc[mi][ni] = MFMA(a, b[ni], acc[mi][ni]);
    }
    buf = buf == 2 ? 0 : buf + 1;
  }
  __syncthreads();
  u16* tile = (u16*)smem;
#pragma unroll
  for (int mi = 0; mi < 4; ++mi)
#pragma unroll
    for (int ni = 0; ni < 2; ++ni)
#pragma unroll
      for (int r = 0; r < 4; ++r) tile[(w * 64 + mi * 16 + q * 4 + r) * 40 + ni * 16 + l] = f2bf(acc[mi][ni][r]);
  __syncthreads();
#pragma unroll
  for (int i = 0; i < 4; ++i) {
    const int id = tid + 256 * i, row = id >> 2, cc = id & 3;
    *(uint4*)(p.R1 + (size_t)(m0 + row) * NPAB + n0 + cc * 8) = *(const uint4*)(tile + row * 40 + cc * 8);
  }
  __syncthreads();
}

__device__ __forceinline__ void gla_step23(f32x4 (&S)[8], const int vrow0, const u16* VT, const u16* ATT, const u16* Qs,
                                           const u16* KT, const float* DEC, u16* O, const int w, const int l,
                                           const int q, const int tokbase, const int dir, const int cpos,
                                           const int ocol) {
    {
      f32x4 oacc[4];
#pragma unroll
      for (int ni = 0; ni < 4; ++ni) oacc[ni] = (f32x4){0.f, 0.f, 0.f, 0.f};
      bf16x8 vfr[2];
#pragma unroll
      for (int ks = 0; ks < 2; ++ks) {
        vfr[ks] = *(const bf16x8*)(VT + (vrow0 + l) * 72 + ((32 * ks + 8 * q) ^ (8 * (((vrow0 + l) >> 3) & 7))));
#pragma unroll
        for (int ni = 0; ni < 4; ++ni) {
          bf16x8 bfr = *(const bf16x8*)(ATT + (16 * ni + l) * 72 + 32 * ks + 8 * q);
          oacc[ni] = MFMA(vfr[ks], bfr, oacc[ni]);
        }
      }
      __builtin_amdgcn_sched_barrier(0);
#pragma unroll
      for (int pp = 0; pp < 4; ++pp) {
        V8 sa;
        sa.w[0] = pack2(S[2 * pp][0], S[2 * pp][1]);
        sa.w[1] = pack2(S[2 * pp][2], S[2 * pp][3]);
        sa.w[2] = pack2(S[2 * pp + 1][0], S[2 * pp + 1][1]);
        sa.w[3] = pack2(S[2 * pp + 1][2], S[2 * pp + 1][3]);
#pragma unroll
        for (int ni = 0; ni < 4; ++ni) {
          V8 bq;
          bq.u2[0] = *(const uint2*)(Qs + (16 * ni + l) * 136 + 32 * pp + 4 * q);
          bq.u2[1] = *(const uint2*)(Qs + (16 * ni + l) * 136 + 32 * pp + 16 + 4 * q);
          oacc[ni] = MFMA(sa.v, bq.v, oacc[ni]);
        }
      }
      __builtin_amdgcn_sched_barrier(0);
#pragma unroll
      for (int ni = 0; ni < 4; ++ni) {
        const int i = 16 * ni + l;
        const int tok = tokbase + (dir ? cpos + 63 - i : cpos + i);
        uint2 o; o.x = pack2(oacc[ni][0], oacc[ni][1]); o.y = pack2(oacc[ni][2], oacc[ni][3]);
        *(uint2*)(O + (size_t)tok * 2048 + ocol + vrow0 + 4 * q) = o;
      }
      __builtin_amdgcn_sched_barrier(0);
#pragma unroll
      for (int mi = 0; mi < 8; ++mi) {
        if ((mi & 1) == 0) __builtin_amdgcn_sched_barrier(0);
#pragma unroll
        for (int ks = 0; ks < 2; ++ks) {
          bf16x8 a = *(const bf16x8*)(KT + (16 * mi + l) * 72 + 32 * ks + 8 * q);
          S[mi] = MFMA(a, vfr[ks], S[mi]);
        }
        const float4 dc = *(const float4*)(DEC + 16 * mi + 4 * q);
        S[mi][0] *= dc.x; S[mi][1] *= dc.y; S[mi][2] *= dc.z; S[mi][3] *= dc.w;
      }
    }
}

__device__ void gla_unit(const Params& p, int li, int unit, char* smem) {
  u16* Qs = (u16*)smem;
  u16* Ks = Qs + 64 * 136;
  u16* KT = Ks + 64 * 136;
  u16* VT = KT + 128 * 72;
  u16* GAh = VT + 64 * 72;
  float* DEC = (float*)(GAh + 64 * 40);
  u16* ATT = (u16*)(DEC + 128);
  const int tid = tid_opaque(), lane = tid & 63, w = tid >> 6, l = lane & 15, q = lane >> 4;
  int b, tokbase, nch, u = unit;
  bool latent;
  if (unit < 512) { latent = true; b = u >> 6; tokbase = TCTX + b * 2048; nch = 32; }
  else { latent = false; u = unit - 512; b = u >> 6; tokbase = b * 256; nch = 4; }
  const int sl = u & 3, dir = (u >> 2) & 1, hd = (u >> 3) & 3, ty = (u >> 5) & 1;
  const int qcol = ty == 0 ? hd * 128 : 3104 + hd * 128;
  const int kcol = ty == 0 ? 512 + hd * 128 : 3616 + hd * 128;
  const int vcol = (ty == 0 ? 1024 : 4128) + hd * 256 + sl * 64;
  const int ocol = ty * 1024 + hd * 256 + sl * 64;
  const u16* PROJ = p.R1;
  u16* O = dir ? p.R3 : p.R2;
  V8 w2h[2];
  float gb[2] = {0.f, 0.f};
  float ldec = 0.f;
#pragma unroll
  for (int ni = 0; ni < 2; ++ni) w2h[ni].u4 = make_uint4(0, 0, 0, 0);
  if (ty == 0) {
#pragma unroll
    for (int ni = 0; ni < 2; ++ni) {
      const int d = 32 * w + 16 * ni + l;
      const float* wp = p.ab_gate_w2 + (size_t)((li * 2 + dir) * 16 + 8 * (q & 1)) * 512 + hd * 128 + d;
      float hv[8];
#pragma unroll
      for (int e = 0; e < 8; ++e) hv[e] = wp[e * 512];
#pragma unroll
      for (int e = 0; e < 4; ++e) w2h[ni].w[e] = pack2(hv[2 * e], hv[2 * e + 1]);
      gb[ni] = p.ab_gate_b[(li * 2 + dir) * 512 + hd * 128 + d];
    }
  } else {
    float expo = 5.f + (7.f / 3.f) * ((float)hd + 0.5f * (float)dir);
    ldec = log1pf(-exp2f(-expo));
  }
  const float qs = ty == 0 ? 0.08838834764831845f : 1.f;
  const float ksc = ty == 0 ? 1.f : 0.08838834764831845f;
  f32x4 S0[8];
  const size_t sbase = ((((size_t)b * 2 + li) * 2 + dir) * 4 + hd) * 128 * 256;
  const int svcol = sl * 64 + 16 * w + l;
  if (latent) {
    const float* sin_ = ty == 0 ? p.state_gla : p.state_ret;
#pragma unroll
    for (int mi = 0; mi < 8; ++mi)
#pragma unroll
      for (int r = 0; r < 4; ++r) S0[mi][r] = sin_[sbase + (size_t)(16 * mi + 4 * q + r) * 256 + svcol];
  } else {
#pragma unroll
    for (int mi = 0; mi < 8; ++mi) S0[mi] = (f32x4){0.f, 0.f, 0.f, 0.f};
  }
  uint4 rq0, rq1, rq2, rq3, rk0, rk1, rk2, rk3, rv0, rv1;
  float4 rga;
  const int qrow = tid >> 4, qcc = tid & 15;
  const int vrow = tid >> 3, vcc = tid & 7;
  const int grow = tid >> 2, gcc = tid & 3;
#define GLA_TOK(CP, ROW) (tokbase + (dir ? (CP) + 63 - (ROW) : (CP) + (ROW)))
#define GLA_PREFETCH(CP)                                                                              \
  {                                                                                                   \
    const u16* b0_ = PROJ + (size_t)GLA_TOK(CP, qrow) * NPAB + qcc * 8;                               \
    const u16* b1_ = PROJ + (size_t)GLA_TOK(CP, qrow + 16) * NPAB + qcc * 8;                          \
    const u16* b2_ = PROJ + (size_t)GLA_TOK(CP, qrow + 32) * NPAB + qcc * 8;                          \
    const u16* b3_ = PROJ + (size_t)GLA_TOK(CP, qrow + 48) * NPAB + qcc * 8;                          \
    rq0 = *(const uint4*)(b0_ + qcol); rk0 = *(const uint4*)(b0_ + kcol);                             \
    rq1 = *(const uint4*)(b1_ + qcol); rk1 = *(const uint4*)(b1_ + kcol);                             \
    rq2 = *(const uint4*)(b2_ + qcol); rk2 = *(const uint4*)(b2_ + kcol);                             \
    rq3 = *(const uint4*)(b3_ + qcol); rk3 = *(const uint4*)(b3_ + kcol);                             \
  }
#define GLA_PREFETCH_V(CP)                                                                            \
  {                                                                                                   \
    rv0 = *(const uint4*)(PROJ + (size_t)GLA_TOK(CP, vrow) * NPAB + vcc * 8 + vcol);                  \
    rv1 = *(const uint4*)(PROJ + (size_t)GLA_TOK(CP, vrow + 32) * NPAB + vcc * 8 + vcol);             \
    rga = *(const float4*)(p.ga32 + (size_t)GLA_TOK(CP, grow) * 32 + dir * 16 + gcc * 4);             \
  }
  {
    const int cpos0 = 64 * (dir ? nch - 1 : 0);
    GLA_PREFETCH(cpos0)
    GLA_PREFETCH_V(cpos0)
  }
#pragma unroll 1
  for (int n = 0; n < nch; ++n) {
    const int cpos = 64 * (dir ? nch - 1 - n : n);
    __syncthreads();
    {
      u16* dq = Qs + qrow * 136 + qcc * 8;
      u16* dk = Ks + qrow * 136 + qcc * 8;
      *(uint4*)(dq) = rq0; *(uint4*)(dq + 16 * 136) = rq1; *(uint4*)(dq + 32 * 136) = rq2; *(uint4*)(dq + 48 * 136) = rq3;
      *(uint4*)(dk) = rk0; *(uint4*)(dk + 16 * 136) = rk1; *(uint4*)(dk + 32 * 136) = rk2; *(uint4*)(dk + 48 * 136) = rk3;
      V8 t0, t1; t0.u4 = rv0; t1.u4 = rv1;
#pragma unroll
      for (int e = 0; e < 8; ++e) {
        u16* vp = VT + (vcc * 8 + e) * 72;
        vp[vrow ^ (8 * vcc)] = t0.h[e]; vp[(vrow + 32) ^ (8 * vcc)] = t1.h[e];
      }
      if (ty == 0) {
        const float h0 = bf2f(f2bf(rga.x)), h1 = bf2f(f2bf(rga.y)), h2 = bf2f(f2bf(rga.z)), h3 = bf2f(f2bf(rga.w));
        uint2 hi, lo;
        hi.x = pack2(h0, h1); hi.y = pack2(h2, h3);
        lo.x = pack2(rga.x - h0, rga.y - h1); lo.y = pack2(rga.z - h2, rga.w - h3);
        *(uint2*)(GAh + grow * 40 + gcc * 4) = hi;
        *(uint2*)(GAh + grow * 40 + 16 + gcc * 4) = lo;
      }
    }
    __syncthreads();
    if (n + 1 < nch) {
      const int cpos2 = 64 * (dir ? nch - 2 - n : n + 1);
      GLA_PREFETCH(cpos2)
    }
    {
      float carry[2] = {0.f, 0.f};
#pragma unroll
      for (int mi = 0; mi < 4; ++mi) {
        bf16x8 a;
        float eqs[4] = {0.f, 0.f, 0.f, 0.f}, eks[4] = {0.f, 0.f, 0.f, 0.f};
        if (ty == 0) a = *(const bf16x8*)(GAh + (16 * mi + l) * 40 + 8 * q);
#pragma unroll
        for (int ni = 0; ni < 2; ++ni) {
          float c[4];
          if (ty == 0) {
            f32x4 lg = (f32x4){0.f, 0.f, 0.f, 0.f};
            lg = MFMA(a, w2h[ni].v, lg);
            float run = 0.f;
#pragma unroll
            for (int r = 0; r < 4; ++r) {
              const float s = lg[r] + gb[ni];
              run += (fminf(s, 0.f) - __logf(1.f + __expf(-fabsf(s)))) * (1.f / 16.f);
              c[r] = run;
            }
            const float T = run;
            const float u1 = __shfl_up(T, 16);
            const float T1 = q >= 1 ? T + u1 : T;
            const float u2 = __shfl_up(T1, 32);
            const float T2 = q >= 2 ? T1 + u2 : T1;
            const float tot = __shfl(T2, 48 + l);
            const float base = carry[ni] + (T2 - T);
#pragma unroll
            for (int r = 0; r < 4; ++r) c[r] += base;
            carry[ni] += tot;
          } else {
#pragma unroll
            for (int r = 0; r < 4; ++r) c[r] = (float)(16 * mi + 4 * q + r + 1) * ldec;
          }
          const int j0 = 16 * mi + 4 * q, d = 32 * w + 16 * ni + l;
          float ks4[4];
          float eq[4], ek[4];
          if (ty == 0 || ni == 0) {
#pragma unroll
            for (int r = 0; r < 4; ++r) { eq[r] = qs * __expf(c[r]); ek[r] = ksc * __expf(-c[r]); }
          }
          if (ty != 0 && ni == 0) {
#pragma unroll
            for (int r = 0; r < 4; ++r) { eqs[r] = eq[r]; eks[r] = ek[r]; }
          }
          if (ty != 0 && ni != 0) {
#pragma unroll
            for (int r = 0; r < 4; ++r) { eq[r] = eqs[r]; ek[r] = eks[r]; }
          }
#pragma unroll
          for (int r = 0; r < 4; ++r) {
            u16* qp = Qs + (j0 + r) * 136 + d;
            u16* kp = Ks + (j0 + r) * 136 + d;
            const float qv = bf2f(*qp), kv = bf2f(*kp);
            *qp = f2bf(qv * eq[r]);
            ks4[r] = kv * ek[r];
            *kp = f2bf(ks4[r]);
          }
          uint2 o; o.x = pack2(ks4[0], ks4[1]); o.y = pack2(ks4[2], ks4[3]);
          *(uint2*)(KT + d * 72 + j0) = o;
        }
      }
      if (q == 0) {
        DEC[32 * w + l] = __expf(ty == 0 ? carry[0] : 64.f * ldec);
        DEC[32 * w + 16 + l] = __expf(ty == 0 ? carry[1] : 64.f * ldec);
      }
    }
    __syncthreads();
    __builtin_amdgcn_sched_barrier(0);
    f32x4 at[4];
#pragma unroll
    for (int ni = 0; ni < 4; ++ni) at[ni] = (f32x4){0.f, 0.f, 0.f, 0.f};
#pragma unroll
    for (int ks = 0; ks < 4; ++ks) {
      bf16x8 a = *(const bf16x8*)(Qs + (16 * w + l) * 136 + 32 * ks + 8 * q);
#pragma unroll
      for (int ni = 0; ni < 4; ++ni) {
        bf16x8 bfr = *(const bf16x8*)(Ks + (16 * ni + l) * 136 + 32 * ks + 8 * q);
        at[ni] = MFMA(a, bfr, at[ni]);
      }
    }
#pragma unroll
    for (int ni = 0; ni < 4; ++ni)
#pragma unroll
      for (int r = 0; r < 4; ++r) {
        const int i = 16 * w + 4 * q + r, j = 16 * ni + l;
        ATT[i * 72 + j] = f2bf(j <= i ? at[ni][r] : 0.f);
      }
    __syncthreads();
    __builtin_amdgcn_sched_barrier(0);
    gla_step23(S0, 16 * w, VT, ATT, Qs, KT, DEC, O, w, l, q, tokbase, dir, cpos, ocol);
    __builtin_amdgcn_sched_barrier(0);
    if (n + 1 < nch) {
      const int cpos3 = 64 * (dir ? nch - 2 - n : n + 1);
      GLA_PREFETCH_V(cpos3)
    }
  }
  if (!latent) {
    float* so = p.out + (ty == 0 ? OFF_GLA : OFF_RET);
#pragma unroll
    for (int mi = 0; mi < 8; ++mi)
#pragma unroll
      for (int r = 0; r < 4; ++r) so[sbase + (size_t)(16 * mi + 4 * q + r) * 256 + svcol] = S0[mi][r];
  }
}

template <int GRP>
__device__ void conv_unit(const Params& p, int li, int c, char* smem) {
  constexpr int L = GRP ? 2048 : 256;
  constexpr int NB = GRP ? 8 : 32;
  constexpr int NI = GRP ? 4 : 2;
  constexpr int NIB = L / 64;
  constexpr int TOK0 = GRP ? TCTX : 0;
  constexpr int HCS = 2 * L + 8;
  constexpr int UBS = L + 8;
  constexpr int CPT = NB * L / 8 / 256;
  u16* HC = (u16*)smem;
  u16* UB = HC + 4 * HCS;
  u16* XR = GRP ? HC : UB + NB * UBS;
  const int tid = tid_opaque(), lane = tid & 63, w = tid >> 6, l = lane & 15, q = lane >> 4;
  const u16* UT = p.R1;
  u16* Z2T = p.H;
  const float* sw = p.hy_short_w + li * 3 * 3072;
  const float* sb = p.hy_short_b + li * 3072;
  __syncthreads();
  {
    const u16* src = UT + (size_t)c * TTOT + TOK0;
    uint4 raw[CPT];
#pragma unroll
    for (int k = 0; k < CPT; ++k) raw[k] = *(const uint4*)(src + (size_t)(tid + 256 * k) * 8);
#pragma unroll
    for (int k = 0; k < CPT; ++k) {
      const int ch = tid + 256 * k, bq = ch / (L / 8), p0 = (ch % (L / 8)) * 8;
      *(uint4*)(UB + bq * UBS + p0) = raw[k];
    }
    __syncthreads();
    const float w0 = sw[c], w1 = sw[3072 + c], w2 = sw[6144 + c], bs = sb[c];
#pragma unroll
    for (int k = 0; k < CPT; ++k) {
      const int ch = tid + 256 * k, bq = ch / (L / 8), p0 = (ch % (L / 8)) * 8;
      const u16* s = UB + bq * UBS + p0;
      V8 rw; rw.u4 = raw[k];
      float x[10];
      x[0] = p0 > 0 ? bf2f(s[-1]) : 0.f;
#pragma unroll
      for (int e = 0; e < 8; ++e) x[e + 1] = bf2f(rw.h[e]);
      x[9] = p0 + 8 < L ? bf2f(s[8]) : 0.f;
      V8 o;
#pragma unroll
      for (int e = 0; e < 4; ++e)
        o.w[e] = pack2(w0 * x[2 * e] + w1 * x[2 * e + 1] + w2 * x[2 * e + 2] + bs,
                       w0 * x[2 * e + 1] + w1 * x[2 * e + 2] + w2 * x[2 * e + 3] + bs);
      raw[k] = o.u4;
    }
    __syncthreads();
#pragma unroll
    for (int k = 0; k < CPT; ++k) {
      const int ch = tid + 256 * k, bq = ch / (L / 8), p0 = (ch % (L / 8)) * 8;
      *(uint4*)(UB + bq * UBS + p0) = raw[k];
    }
  }
  const int ncol0 = w * 16 * NI;
  const int Imin = ncol0 / NB, Imax = (ncol0 + 16 * NI - 1) / NB;
  const int cp = (-l) & 3;
#pragma unroll 1
  for (int o = 0; o < 2; ++o) {
    const u16* hr = p.hrev + hrev_off(li, GRP, o, c);
    for (int g = tid; g < 2 * L / 8; g += 256) {
      uint4 A = *(const uint4*)(hr + 8 * g);
      uint4 B = make_uint4(0, 0, 0, 0);
      if (g + 1 < 2 * L / 8) B = *(const uint4*)(hr + 8 * g + 8);
      unsigned wd[8] = {A.x, A.y, A.z, A.w, B.x, B.y, B.z, B.w};
#pragma unroll
      for (int cq = 0; cq < 4; ++cq) {
        uint4 ov;
        unsigned t[4];
#pragma unroll
        for (int k = 0; k < 4; ++k)
          t[k] = (cq & 1) ? ((wd[k + cq / 2] >> 16) | (wd[k + cq / 2 + 1] << 16)) : wd[k + cq / 2];
        ov.x = t[0]; ov.y = t[1]; ov.z = t[2]; ov.w = t[3];
        *(uint4*)(HC + cq * HCS + 8 * g) = ov;
      }
    }
    __syncthreads();
    const int gch = (o + 1) * 1024 + c;
    uint4 xr0, xr1, xr2, xr3, xr4 = make_uint4(0, 0, 0, 0), xr5 = xr4, xr6 = xr4, xr7 = xr4;
    {
      const u16* xsrc = UT + (size_t)gch * TTOT + TOK0 + (size_t)tid * 8;
      xr0 = *(const uint4*)(xsrc); xr1 = *(const uint4*)(xsrc + 2048); xr2 = *(const uint4*)(xsrc + 4096); xr3 = *(const uint4*)(xsrc + 6144);
      if (CPT == 8) {
        xr4 = *(const uint4*)(xsrc + 8192); xr5 = *(const uint4*)(xsrc + 10240); xr6 = *(const uint4*)(xsrc + 12288); xr7 = *(const uint4*)(xsrc + 14336);
      }
    }
    f32x4 acc[4][NI];
#pragma unroll
    for (int mi = 0; mi < 4; ++mi)
#pragma unroll
      for (int ni = 0; ni < NI; ++ni) acc[mi][ni] = (f32x4){0.f, 0.f, 0.f, 0.f};
    bf16x8 fr[6];
    {
      const int dd0 = Imin - (NIB - 1);
#pragma unroll
      for (int e6 = 4; e6 < 6; ++e6) {
        const int x0 = L - 64 * dd0 + 16 * (e6 - 3) + 8 * q - l;
        const u16* a = HC + cp * HCS + (x0 - cp);
        V8 t;
        t.u2[0] = *(const uint2*)a;
        t.u2[1] = *(const uint2*)(a + 4);
        fr[e6] = t.v;
      }
    }
#pragma unroll 1
    for (int dd = Imin - (NIB - 1); dd <= Imax; ++dd) {
      if (dd > Imin - (NIB - 1)) { fr[4] = fr[0]; fr[5] = fr[1]; }
#pragma unroll
      for (int e6 = 0; e6 < 4; ++e6) {
        const int x0 = L - 64 * dd + 16 * (e6 - 3) + 8 * q - l;
        const u16* a = HC + cp * HCS + (x0 - cp);
        V8 t;
        t.u2[0] = *(const uint2*)a;
        t.u2[1] = *(const uint2*)(a + 4);
        fr[e6] = t.v;
      }
#pragma unroll
      for (int ks = 0; ks < 2; ++ks) {
#pragma unroll
        for (int ni = 0; ni < NI; ++ni) {
          const int Ilo = (ncol0 + 16 * ni) / NB, Ihi = (ncol0 + 16 * ni + 15) / NB;
          if (Ihi - dd < 0 || Ilo - dd >= NIB) continue;
          const int n = ncol0 + 16 * ni + l;
          const int I = n / NB, bb = n % NB;
          const int J = I - dd;
          V8 bfr; bfr.u4 = make_uint4(0, 0, 0, 0);
          if (J >= 0 && J < NIB) bfr.u4 = *(const uint4*)(UB + bb * UBS + 64 * J + 32 * ks + 8 * q);
#pragma unroll
          for (int mi = 0; mi < 4; ++mi) acc[mi][ni] = MFMA(fr[2 * ks - mi + 3], bfr.v, acc[mi][ni]);
        }
      }
    }
    __syncthreads();
    {
      u16* xd = XR + (size_t)tid * 8;
      *(uint4*)(xd) = xr0; *(uint4*)(xd + 2048) = xr1; *(uint4*)(xd + 4096) = xr2; *(uint4*)(xd + 6144) = xr3;
      if (CPT == 8) {
        *(uint4*)(xd + 8192) = xr4; *(uint4*)(xd + 10240) = xr5; *(uint4*)(xd + 12288) = xr6; *(uint4*)(xd + 14336) = xr7;
      }
    }
    __syncthreads();
    const float w0 = sw[gch], w1 = sw[3072 + gch], w2 = sw[6144 + gch], bs = sb[gch];
#pragma unroll
    for (int mi = 0; mi < 4; ++mi) {
#pragma unroll
      for (int ni = 0; ni < NI; ++ni) {
        const int n = ncol0 + 16 * ni + l;
        const int I = n / NB, bb = n % NB;
        const int pp = 64 * I + 16 * mi + 4 * q;
        const u16* s = XR + bb * L + pp;
        const uint2 raw = *(const uint2*)s;
        float x[6];
        x[0] = pp > 0 ? bf2f(s[-1]) : 0.f;
        x[1] = bflo(raw.x); x[2] = bfhi(raw.x); x[3] = bflo(raw.y); x[4] = bfhi(raw.y);
        x[5] = pp + 4 < L ? bf2f(s[4]) : 0.f;
        float z[4];
#pragma unroll
        for (int r = 0; r < 4; ++r) z[r] = (w0 * x[r] + w1 * x[r + 1] + w2 * x[r + 2] + bs) * acc[mi][ni][r];
        uint2 ov; ov.x = pack2(z[0], z[1]); ov.y = pack2(z[2], z[3]);
        *(uint2*)(UB + bb * UBS + pp) = ov;
      }
    }
    __syncthreads();
  }
  {
    u16* dst = Z2T + (size_t)c * TTOT + TOK0;
#pragma unroll
    for (int k = 0; k < CPT; ++k) {
      const int ch = tid + 256 * k, bq = ch / (L / 8), p0 = (ch % (L / 8)) * 8;
      *(uint4*)(dst + (size_t)ch * 8) = *(const uint4*)(UB + bq * UBS + p0);
    }
  }
}

__device__ void lrua_unit(const Params& p, int li, int u, char* smem) {
  u16* XC = (u16*)smem;
  const int tid = tid_opaque(), lane = tid & 63, w = tid >> 6, l = lane & 15, q = lane >> 4;
  const int tt = u >> 3, blk = u & 7, t0 = tt * 64;
  int L, sbase;
  if (t0 < TCTX) { L = 256; sbase = (t0 >> 8) << 8; }
  else { L = 2048; sbase = TCTX + (((t0 - TCTX) >> 11) << 11); }
  const int p0 = t0 - sbase;
  const u16* PR = p.R1 + (size_t)3072 * TTOT;
  u16* LA = p.R2; u16* BB = p.R3;
  __syncthreads();
  {
    const int cc = tid & 15, ch = blk * 128 + cc * 8;
    float wk[4][8], bias[8];
    {
      const float4 b0 = *(const float4*)(p.lru_conv_b + li * 1024 + ch), b1 = *(const float4*)(p.lru_conv_b + li * 1024 + ch + 4);
      bias[0] = b0.x; bias[1] = b0.y; bias[2] = b0.z; bias[3] = b0.w; bias[4] = b1.x; bias[5] = b1.y; bias[6] = b1.z; bias[7] = b1.w;
#pragma unroll
      for (int k = 0; k < 4; ++k) {
        const float* wp = p.lru_conv_w + (li * 4 + k) * 1024 + ch;
        const float4 w0 = *(const float4*)wp, w1 = *(const float4*)(wp + 4);
        wk[k][0] = w0.x; wk[k][1] = w0.y; wk[k][2] = w0.z; wk[k][3] = w0.w;
        wk[k][4] = w1.x; wk[k][5] = w1.y; wk[k][6] = w1.z; wk[k][7] = w1.w;
      }
    }
#pragma unroll 2
    for (int it = 0; it < 4; ++it) {
      const int row = (tid >> 4) + 16 * it;
      uint4 xr[4];
#pragma unroll
      for (int k = 0; k < 4; ++k) {
        const int pp = p0 + row + k - 2;
        xr[k] = (pp >= 0 && pp < L) ? *(const uint4*)(PR + (size_t)(sbase + pp) * 3072 + 1024 + ch) : make_uint4(0, 0, 0, 0);
      }
      float a8[8];
#pragma unroll
      for (int e = 0; e < 8; ++e) a8[e] = bias[e];
#pragma unroll
      for (int k = 0; k < 4; ++k) {
        V8 raw; raw.u4 = xr[k];
#pragma unroll
        for (int e = 0; e < 8; ++e) a8[e] += wk[k][e] * bf2f(raw.h[e]);
      }
      uint4 ov; ov.x = pack2(a8[0], a8[1]); ov.y = pack2(a8[2], a8[3]); ov.z = pack2(a8[4], a8[5]); ov.w = pack2(a8[6], a8[7]);
      *(uint4*)(XC + row * 136 + cc * 8) = ov;
    }
  }
  __syncthreads();
  u16* LAt = XC + 64 * 136;
  u16* BBt = LAt + 64 * 136;
#pragma unroll
  for (int dir = 0; dir < 2; ++dir) {
#pragma unroll
    for (int ni = 0; ni < 2; ++ni) {
      f32x4 ar[4], ai[4];
#pragma unroll
      for (int mi = 0; mi < 4; ++mi) { ar[mi] = (f32x4){0.f, 0.f, 0.f, 0.f}; ai[mi] = (f32x4){0.f, 0.f, 0.f, 0.f}; }
      const u16* wr = p.wlru + (size_t)((((li * 2 + dir) * 8 + blk) * 2) + 0) * 16384;
      const u16* wi = wr + 16384;
      const int nrow = 32 * w + 16 * ni + l;
#pragma unroll
      for (int ks = 0; ks < 4; ++ks) {
        bf16x8 br = *(const bf16x8*)(wr + nrow * 128 + 32 * ks + 8 * q);
        bf16x8 bi = *(const bf16x8*)(wi + nrow * 128 + 32 * ks + 8 * q);
#pragma unroll
        for (int mi = 0; mi < 4; ++mi) {
          bf16x8 a = *(const bf16x8*)(XC + (16 * mi + l) * 136 + 32 * ks + 8 * q);
          ar[mi] = MFMA(a, br, ar[mi]);
          ai[mi] = MFMA(a, bi, ai[mi]);
        }
      }
      const int chl = nrow, C = blk * 128 + chl;
      const float brv = p.lru_b_r[(li * 2 + dir) * 1024 + C], biv = p.lru_b_i[(li * 2 + dir) * 1024 + C];
      const float lam = p.lru_lambda[(li * 2 + dir) * 1024 + C];
      const float sp = log1pf(expf(-lam));
#pragma unroll
      for (int mi = 0; mi < 4; ++mi)
#pragma unroll
        for (int r = 0; r < 4; ++r) {
          const int row = 16 * mi + 4 * q + r;
          const float rr = sigmoidf_(ar[mi][r] + brv), ig = sigmoidf_(ai[mi][r] + biv);
          const float la = -8.f * rr * sp;
          const float e2 = __expf(2.f * la);
          const float om = la > -0.05f ? -2.f * la * (1.f + la * (1.f + la * (2.f / 3.f))) : 1.f - e2;
          const float bbv = __builtin_amdgcn_sqrtf(om) * ig * bf2f(XC[row * 136 + chl]);
          LAt[row * 136 + chl] = f2bf(la);
          BBt[row * 136 + chl] = f2bf(bbv);
        }
    }
    __syncthreads();
    {
      const int ch = tid & 127, hf = tid >> 7;
      float P = 1.f, Hh = 0.f;
#pragma unroll 8
      for (int s = 0; s < 32; ++s) {
        const int row = 32 * hf + (dir ? 31 - s : s);
        const float a = __expf(bf2f(LAt[row * 136 + ch]));
        Hh = a * Hh + bf2f(BBt[row * 136 + ch]);
        P *= a;
      }
      const size_t so = ((size_t)dir * (TTOT / 32) + (t0 >> 5) + hf) * 1024 + blk * 128 + ch;
      p.pseg[so] = P;
      p.hseg[so] = Hh;
    }
#pragma unroll
    for (int i = 0; i < 4; ++i) {
      const int id = tid + 256 * i, row = id >> 4, cc = id & 15;
      const size_t go = ((size_t)dir * TTOT + t0 + row) * 1024 + blk * 128 + cc * 8;
      *(uint4*)(LA + go) = *(const uint4*)(LAt + row * 136 + cc * 8);
      *(uint4*)(BB + go) = *(const uint4*)(BBt + row * 136 + cc * 8);
    }
    __syncthreads();
  }
}

template <int LOGCO>
__device__ void lrub_unit(const Params& p, int li, int u, char* smem) {
  constexpr int NCO = 1 << LOGCO, NSEG = 256 >> LOGCO, CW = 8 * NCO;
  float* PS = (float*)smem;
  float* HS = PS + 2048;
  const int tid = tid_opaque();
  const int co = tid & (NCO - 1), seg = tid >> LOGCO;
  int b, L, base, cg_;
  bool latent;
  if (LOGCO == 2) { latent = true; b = u >> 5; cg_ = u & 31; L = 2048; base = TCTX + b * 2048; }
  else { latent = false; b = u >> 2; cg_ = u & 3; L = 256; base = b * 256; }
  const int C0 = cg_ * CW + co * 8;
  const int SL = L / NSEG;
  const u16* LA = p.R2; const u16* BB = p.R3;
  const u16* PR = p.R1 + (size_t)3072 * TTOT;
  u16* Y = p.R1;
#pragma unroll
  for (int dir = 0; dir < 2; ++dir) {
    const u16* la_ = LA + (size_t)dir * TTOT * 1024 + C0;
    const u16* bb_ = BB + (size_t)dir * TTOT * 1024 + C0;
    __syncthreads();
    {
      const int tseg = dir ? NSEG - 1 - seg : seg;
      const size_t so = ((size_t)dir * (TTOT / 32) + (base >> 5) + tseg) * 1024 + C0;
      *(float4*)(PS + seg * CW + co * 8) = *(const float4*)(p.pseg + so);
      *(float4*)(PS + seg * CW + co * 8 + 4) = *(const float4*)(p.pseg + so + 4);
      *(float4*)(HS + seg * CW + co * 8) = *(const float4*)(p.hseg + so);
      *(float4*)(HS + seg * CW + co * 8 + 4) = *(const float4*)(p.hseg + so + 4);
    }
    __syncthreads();
    float h[8];
    if (latent) {
      const float* sp_ = p.state_lru + ((b * 2 + li) * 2 + dir) * 1024 + C0;
      float4 s0 = *(const float4*)sp_, s1 = *(const float4*)(sp_ + 4);
      h[0] = s0.x; h[1] = s0.y; h[2] = s0.z; h[3] = s0.w; h[4] = s1.x; h[5] = s1.y; h[6] = s1.z; h[7] = s1.w;
    } else {
#pragma unroll
      for (int e = 0; e < 8; ++e) h[e] = 0.f;
    }
    for (int s2 = 0; s2 < seg; ++s2) {
      float4 p0 = *(const float4*)(PS + s2 * CW + co * 8), p1 = *(const float4*)(PS + s2 * CW + co * 8 + 4);
      float4 q0 = *(const float4*)(HS + s2 * CW + co * 8), q1 = *(const float4*)(HS + s2 * CW + co * 8 + 4);
      h[0] = p0.x * h[0] + q0.x; h[1] = p0.y * h[1] + q0.y; h[2] = p0.z * h[2] + q0.z; h[3] = p0.w * h[3] + q0.w;
      h[4] = p1.x * h[4] + q1.x; h[5] = p1.y * h[5] + q1.y; h[6] = p1.z * h[6] + q1.z; h[7] = p1.w * h[7] + q1.w;
    }
#pragma unroll 4
    for (int s = 0; s < SL; ++s) {
      const int pos = dir ? L - 1 - (seg * SL + s) : seg * SL + s;
      const int tkn = base + pos;
      const size_t off = (size_t)tkn * 1024;
      V8 la, bb; la.u4 = *(const uint4*)(la_ + off); bb.u4 = *(const uint4*)(bb_ + off);
#pragma unroll
      for (int e = 0; e < 8; ++e) h[e] = __expf(bf2f(la.h[e])) * h[e] + bf2f(bb.h[e]);
      u16* yp = Y + (size_t)tkn * 2048 + 1024 + C0;
      V8 o;
      if (dir == 0) {
#pragma unroll
        for (int e = 0; e < 4; ++e) o.w[e] = pack2(h[2 * e], h[2 * e + 1]);
      } else {
        V8 hf, zr; hf.u4 = *(const uint4*)yp; zr.u4 = *(const uint4*)(PR + (size_t)tkn * 3072 + 2048 + C0);
#pragma unroll
        for (int e = 0; e < 4; ++e)
          o.w[e] = pack2((bf2f(hf.h[2 * e]) + h[2 * e]) * siluf_(bf2f(zr.h[2 * e])),
                         (bf2f(hf.h[2 * e + 1]) + h[2 * e + 1]) * siluf_(bf2f(zr.h[2 * e + 1])));
      }
      *(uint4*)yp = o.u4;
    }
    if (!latent && seg == NSEG - 1) {
      float* so = p.out + OFF_LRU + ((b * 2 + li) * 2 + dir) * 1024 + C0;
      *(float4*)so = make_float4(h[0], h[1], h[2], h[3]);
      *(float4*)(so + 4) = make_float4(h[4], h[5], h[6], h[7]);
    }
  }
}

__device__ void c2_trans_unit(const Params& p, int u, char* smem) {
  u16* tile = (u16*)smem;
  const int tid = tid_opaque();
  const int tt = u >> 4, ct = u & 15, t0 = tt * 64, c0 = ct * 64;
  const u16* Z2T = p.H;
  const u16* PR = p.R1 + (size_t)3072 * TTOT;
  u16* Y = p.R1;
  __syncthreads();
  {
    const int r = tid >> 2, part = tid & 3;
    const u16* s = Z2T + (size_t)(c0 + r) * TTOT + t0 + part * 16;
    *(uint4*)(tile + r * 72 + part * 16) = *(const uint4*)s;
    *(uint4*)(tile + r * 72 + part * 16 + 8) = *(const uint4*)(s + 8);
  }
  __syncthreads();
  {
    const int t = tid >> 2, cpart = tid & 3;
    const u16* zp = PR + (size_t)(t0 + t) * 3072 + c0 + cpart * 16;
    V8 z0, z1; z0.u4 = *(const uint4*)zp; z1.u4 = *(const uint4*)(zp + 8);
    V8 o0, o1;
#pragma unroll
    for (int e = 0; e < 8; ++e) {
      o0.h[e] = f2bf(bf2f(tile[(cpart * 16 + e) * 72 + t]) * siluf_(bf2f(z0.h[e])));
      o1.h[e] = f2bf(bf2f(tile[(cpart * 16 + 8 + e) * 72 + t]) * siluf_(bf2f(z1.h[e])));
    }
    u16* yp = Y + (size_t)(t0 + t) * 2048 + c0 + cpart * 16;
    *(uint4*)yp = o0.u4;
    *(uint4*)(yp + 8) = o1.u4;
  }
}

__global__ void __launch_bounds__(256, 2) mega(Params p, int ph0, int ph1) {
  extern __shared__ __attribute__((aligned(16))) char smem[];
  __shared__ uint4 xb_words;
  cg::grid_group grid = cg::this_grid();
  if (threadIdx.x == 0) xb_words = make_uint4(0u, 0u, 0u, 0u);
  __syncthreads();
  XcdBarrier xb = xcd_barrier_post(p.bar, (volatile LAS unsigned*)&xb_words);
  const int vb = blockIdx.x, G = gridDim.x;
  for (int ph = ph0; ph < ph1; ++ph) {
    if (ph == 0) {
      for (int u = vb; u < 10048; u += G) {
        if (u < 1152) p0_hyf(p, u, smem);
        else if (u < 1536) p0_mod(p, u - 1152, smem);
        else p0_trans(p, u - 1536, smem);
      }
    } else if (ph == NPHASE - 1) {
      final_norm(p, vb, G);
    } else {
      const int layer = (ph - 1) / 5, sub = (ph - 1) % 5, li = layer >> 1;
      const bool ab = (layer & 1) == 0;
      const float* xp = layer == 0 ? p.x_prompt : p.out;
      const float* xs = layer == 0 ? p.x_sample : p.out + (size_t)TCTX * 1024;
      if (sub == 0) {
        norm_rows(p, layer, xp, xs, vb, G);
      } else if (sub == 1) {
        if (ab) {
          const u16* Bt = p.wab_in + (size_t)li * NPAB * 1024;
          for (int i = 0;; ++i) {
            const int seq = (i * 8 + (vb & 7)) * (G >> 3) + (vb >> 3);
            if (seq >= 96 * 48) break;
            const int panel = seq / (8 * 48), rem = seq - panel * (8 * 48);
            gemm_big<0>(p, p.H, Bt, (panel * 8 + ((rem >> 3) & 7)) * 256, ((rem >> 6) * 8 + (rem & 7)) * 128, smem);
          }
          for (int t = vb; t < 96; t += G) gemm_thin(p, p.H, Bt, t * 256, smem);
        } else {
          const u16* Bt = p.wcd_in + (size_t)li * 6144 * 1024;
          for (int i = 0;; ++i) {
            const int seq = (i * 8 + (vb & 7)) * (G >> 3) + (vb >> 3);
            if (seq >= 96 * 48) break;
            const int panel = seq / (8 * 48), rem = seq - panel * (8 * 48);
            gemm_big<1>(p, p.H, Bt, (panel * 8 + ((rem >> 3) & 7)) * 256, ((rem >> 6) * 8 + (rem & 7)) * 128, smem);
          }
        }
      } else if (sub == 2) {
        if (ab) {
          for (int u = vb; u < 2560; u += G) {
            const int r = u % G, base = u - r;
            const int v = G == 512 ? base + 64 * (r & 7) + (r >> 3) : u;
            gla_unit(p, li, v < 512 ? v : 512 + ((v - 512) ^ 32), smem);
          }
        } else {
          const int nk_ = (5120 - vb + G - 1) / G;
          for (int k_ = 0; k_ < nk_; ++k_) {
            const int u = vb + (((vb >> 3) & 1) ? nk_ - 1 - k_ : k_) * G;
            if (u < 1024) conv_unit<1>(p, li, u, smem);
            else if (u < 2048) conv_unit<0>(p, li, u - 1024, smem);
            else lrua_unit(p, li, u - 2048, smem);
          }
        }
      } else if (sub == 3) {
        if (ab) headnorm_rows(p, li, vb, G);
        else {
          for (int u = vb; u < 384 + 6144; u += G) {
            if (u < 256) lrub_unit<2>(p, li, G == 512 ? 32 * (u & 7) + (u >> 3) : u, smem);
            else if (u < 384) lrub_unit<5>(p, li, u - 256, smem);
            else c2_trans_unit(p, u - 384, smem);
          }
        }
      } else {
        const u16* A = ab ? p.R2 : p.R1;
        const u16* Bt = (ab ? p.wab_out : p.wcd_out) + (size_t)li * 1024 * 2048;
        if (G == 512) {
          const int seq = (vb & 7) * 64 + (vb >> 3);
          const int panel = seq >> 6, rem = seq & 63;
          gemm_big<2>(p, A, Bt, (panel * 8 + (rem >> 3)) * 256, (rem & 7) * 128, smem, 2048, layer, xp, xs);
          gemm_tile<2>(p, A, 2048, Bt, 2048, 16384 + (panel * 8 + (rem >> 3)) * 128, (rem & 7) * 128, layer, xp, xs, smem, p.out);
        } else {
          for (int i = 0;; ++i) {
            const int seq = (i * 8 + (vb & 7)) * (G >> 3) + (vb >> 3);
            if (seq >= 192 * 8) break;
            const int panel = seq / 64, rem = seq - panel * 64;
            gemm_tile<2>(p, A, 2048, Bt, 2048, (panel * 8 + (rem & 7)) * 128, (rem >> 3) * 128, layer, xp, xs, smem, p.out);
          }
        }
      }
    }
    if (ph + 1 < ph1) {
      if (ph1 > NPHASE) grid.sync();
      xcd_barrier(xb);
    }
  }
}

extern "C" void kernel_launch(void* const* d_in, const int* in_sizes, int n_in, void* d_out, int out_size, void* d_ws,
                              size_t ws_size, hipStream_t stream) {
  static int grid_blocks = 0;
  if (!grid_blocks) {
    int dev = 0, cus = 0, per_cu = 0;
    hipGetDevice(&dev);
    hipDeviceGetAttribute(&cus, hipDeviceAttributeMultiprocessorCount, dev);
    hipFuncSetAttribute((const void*)mega, hipFuncAttributeMaxDynamicSharedMemorySize, SMEM_BYTES);
    hipOccupancyMaxActiveBlocksPerMultiprocessor(&per_cu, mega, 256, SMEM_BYTES);
    if (per_cu > 2) per_cu = 2;
    if (per_cu < 1) per_cu = 1;
    grid_blocks = cus * per_cu;
  }
  Params p{};
  const float** pf = (const float**)&p;
  for (int i = 0; i < 36; ++i) pf[i] = (const float*)d_in[i];
  p.out = (float*)d_out;
  char* ws = (char*)d_ws;
  size_t off = 0;
  auto take = [&](size_t bytes) { char* r = ws + off; off += (bytes + 255) & ~(size_t)255; return r; };
  p.mod = (float*)take((size_t)4 * 9 * 3072 * 4);
  p.ga32 = (float*)take((size_t)TTOT * 32 * 4);
  p.wab_in = (u16*)take((size_t)2 * NPAB * 1024 * 2);
  p.wab_out = (u16*)take((size_t)2 * 1024 * 2048 * 2);
  p.wcd_in = (u16*)take((size_t)2 * 6144 * 1024 * 2);
  p.wcd_out = (u16*)take((size_t)2 * 1024 * 2048 * 2);
  p.wlru = (u16*)take((size_t)64 * 16384 * 2);
  p.hrev = (u16*)take((size_t)2 * 9437184 * 2);
  p.H = (u16*)take((size_t)TTOT * 1024 * 2);
  p.R1 = (u16*)take((size_t)TTOT * NPAB * 2);
  p.R2 = (u16*)take((size_t)TTOT * 2048 * 2);
  p.R3 = (u16*)take((size_t)TTOT * 2048 * 2);
  p.bar = (unsigned*)take((size_t)XCD_BAR_WORDS * 4);
  hipMemsetAsync(p.bar, 0, (size_t)XCD_BAR_WORDS * 4, stream);
  p.pseg = (float*)take((size_t)2 * (TTOT / 32) * 1024 * 4);
  p.hseg = (float*)take((size_t)2 * (TTOT / 32) * 1024 * 4);
  int ph0 = 0, ph1 = NPHASE;
#ifdef MULTI
  for (int ph = 0; ph < NPHASE; ++ph) {
    ph0 = ph; ph1 = ph + 1;
    void* args[] = {&p, &ph0, &ph1};
    hipLaunchCooperativeKernel((void*)mega, dim3(grid_blocks), dim3(256), args, SMEM_BYTES, stream);
  }
#else
  void* args[] = {&p, &ph0, &ph1};
  hipError_t e = hipLaunchCooperativeKernel((void*)mega, dim3(grid_blocks), dim3(256), args, SMEM_BYTES, stream);
  if (e != hipSuccess) fprintf(stderr, "cooperative launch failed: %s (grid %d)\n", hipGetErrorString(e), grid_blocks);
#endif
}
```
